# Optimizing an MI355X kernel written in HIP

```python
import math
import jax, jax.numpy as jnp
from jax import lax
import numpy as np

D_MODEL = 1024
BATCH = 16
SEQ = 256
DEPTH = 1
DEC_BATCH = 8
DEC_SEQ = 4096
PAST_LEN = 256

GRID_W = 64
D_MIX = D_MODEL
D_ATT = D_MIX // 2
D_CONV = D_MIX - D_ATT
HEAD_DIM = 64
V_DIM = 2 * HEAD_DIM
N_ATT_HEADS = D_ATT // V_DIM
CONV_W = 3
ROPE_FREQS = HEAD_DIM // 4
ROPE_BASE = 10000.0
Q_BLOCK = 128
EPS = 1e-6
SPLITS = (D_ATT, D_ATT, D_ATT, D_ATT, D_CONV, D_CONV, D_CONV, D_CONV)
D_IN = sum(SPLITS)

kernel_name = "hymba_diffattn_shortconv_dit_step"


def _rms(x, w):
    xf = x.astype(jnp.float32)
    y = xf * lax.rsqrt(jnp.mean(xf * xf, axis=-1, keepdims=True) + EPS)
    return (y * w.astype(jnp.float32)).astype(x.dtype)


def _modulation(cvec, w_ada, b_ada):
    m = jax.nn.silu(cvec) @ w_ada + b_ada
    return jnp.split(m, 3, axis=-1)


def _lambda_init(layer):
    return 0.8 - 0.6 * math.exp(-0.3 * layer)


def _axial_rope_tables(n):
    rows = n // GRID_W
    t = jnp.arange(rows * GRID_W)
    row = (t // GRID_W).astype(jnp.float32)
    col = (t % GRID_W).astype(jnp.float32)
    inv = 1.0 / (ROPE_BASE ** (jnp.arange(ROPE_FREQS, dtype=jnp.float32) / ROPE_FREQS))
    ang_r = row[:, None] * inv
    ang_c = col[:, None] * inv
    shp = (1, n, 1, 1, ROPE_FREQS)
    return (jnp.cos(ang_r).reshape(shp), jnp.sin(ang_r).reshape(shp),
            jnp.cos(ang_c).reshape(shp), jnp.sin(ang_c).reshape(shp))


def _rope_half(x, cos, sin):
    x1, x2 = jnp.split(x, 2, axis=-1)
    cos = cos.astype(x.dtype)
    sin = sin.astype(x.dtype)
    return jnp.concatenate([x1 * cos - x2 * sin, x2 * cos + x1 * sin], axis=-1)


def _apply_axial_rope(x, tables):
    cos_r, sin_r, cos_c, sin_c = tables
    xr, xc = jnp.split(x, 2, axis=-1)
    return jnp.concatenate([_rope_half(xr, cos_r, sin_r), _rope_half(xc, cos_c, sin_c)], axis=-1)


def _diff_attention(q, k, v, lam):
    b, nq = q.shape[0], q.shape[1]
    nblk = nq // Q_BLOCK
    qb = q.reshape(b, nblk, Q_BLOCK, N_ATT_HEADS, 2, HEAD_DIM).swapaxes(0, 1)
    scale = HEAD_DIM ** -0.5

    def one(qblk):
        s = jnp.einsum('bqhmd,bkhmd->bhmqk', qblk, k).astype(jnp.float32) * scale
        p = jax.nn.softmax(s, axis=-1)
        a = p[:, :, 0] - lam * p[:, :, 1]
        return jnp.einsum('bhqk,bkhe->bqhe', a.astype(v.dtype), v)

    out = lax.map(one, qb)
    return out.swapaxes(0, 1).reshape(b, nq, N_ATT_HEADS, V_DIM)


def _short_conv(u, w, b):
    up = jnp.pad(u, ((0, 0), (1, 1), (0, 0)))
    return up[:, :-2] * w[0] + up[:, 1:-1] * w[1] + up[:, 2:] * w[2] + b


def _project(x, shift, scale, norm_w, w_in, q_norm_w, k_norm_w):
    b, n = x.shape[0], x.shape[1]
    h = _rms(x, norm_w) * (1 + scale) + shift
    z = h @ w_in
    idx = list(np.cumsum(SPLITS)[:-1])
    q, k, v, g_att, cb, cc, ch, g_conv = jnp.split(z, idx, axis=-1)
    q = _rms(q.reshape(b, n, N_ATT_HEADS, 2, HEAD_DIM), q_norm_w)
    k = _rms(k.reshape(b, n, N_ATT_HEADS, 2, HEAD_DIM), k_norm_w)
    v = v.reshape(b, n, N_ATT_HEADS, V_DIM)
    return q, k, v, g_att, cb, cc, ch, g_conv


def _finish(x, att, g_att, cb, cc, ch, g_conv, gate, subln_w, conv_w, conv_b, w_out, lam_init):
    b, n = x.shape[0], x.shape[1]
    att = _rms(att, subln_w) * (1.0 - lam_init)
    att = att.reshape(b, n, D_ATT) * jax.nn.silu(g_att)
    conv = cb * _short_conv(cc * ch, conv_w, conv_b) * jax.nn.silu(g_conv)
    y = jnp.concatenate([att, conv], axis=-1) @ w_out
    return x + gate * y


def setup_inputs(seed: int = 0) -> dict:
    key = jax.random.key(seed)
    ks = jax.random.split(key, 20)
    f = jnp.float32
    nrm = lambda k, s, sc: jax.random.normal(k, s, f) * sc
    return {
        "x_prompt": nrm(ks[0], (BATCH, SEQ, D_MODEL), 1.0),
        "x_sample": nrm(ks[1], (DEC_BATCH, DEC_SEQ, D_MODEL), 1.0),
        "cache_k": nrm(ks[2], (DEC_BATCH, DEPTH, PAST_LEN, N_ATT_HEADS, 2, HEAD_DIM), 1.0),
        "cache_v": nrm(ks[3], (DEC_BATCH, DEPTH, PAST_LEN, N_ATT_HEADS, V_DIM), 1.0),
        "c": nrm(ks[4], (DEC_BATCH, D_MODEL), 1.0),
        "c_ctx": nrm(ks[5], (D_MODEL,), 1.0),
        "norm_w": 1.0 + nrm(ks[6], (DEPTH, D_MODEL), 0.02),
        "w_ada": nrm(ks[7], (DEPTH, D_MODEL, 3 * D_MODEL), 0.5 * D_MODEL ** -0.5),
        "b_ada": nrm(ks[8], (DEPTH, 3 * D_MODEL), 0.02),
        "w_in": nrm(ks[9], (DEPTH, D_MODEL, D_IN), D_MODEL ** -0.5),
        "q_norm_w": 1.0 + nrm(ks[10], (DEPTH, HEAD_DIM), 0.02),
        "k_norm_w": 1.0 + nrm(ks[11], (DEPTH, HEAD_DIM), 0.02),
        "lambda_q1": nrm(ks[12], (DEPTH, HEAD_DIM), 0.1),
        "lambda_k1": nrm(ks[13], (DEPTH, HEAD_DIM), 0.1),
        "lambda_q2": nrm(ks[14], (DEPTH, HEAD_DIM), 0.1),
        "lambda_k2": nrm(ks[15], (DEPTH, HEAD_DIM), 0.1),
        "subln_w": 1.0 + nrm(ks[16], (DEPTH, V_DIM), 0.02),
        "conv_w": nrm(ks[17], (DEPTH, CONV_W, D_CONV), CONV_W ** -0.5),
        "conv_b": nrm(ks[18], (DEPTH, D_CONV), 0.02),
        "w_out": nrm(ks[19], (DEPTH, D_MIX, D_MODEL), D_MIX ** -0.5),
    }


def reference(x_prompt, x_sample, cache_k, cache_v, c, c_ctx, norm_w, w_ada, b_ada, w_in,
              q_norm_w, k_norm_w, lambda_q1, lambda_k1, lambda_q2, lambda_k2, subln_w,
              conv_w, conv_b, w_out):
    rope = _axial_rope_tables(x_sample.shape[1])
    xp = x_prompt
    xs = x_sample
    new_k = []
    new_v = []
    for i in range(DEPTH):
        lam_init = _lambda_init(i)
        lam = (jnp.exp(jnp.sum(lambda_q1[i].astype(jnp.float32) * lambda_k1[i].astype(jnp.float32)))
               - jnp.exp(jnp.sum(lambda_q2[i].astype(jnp.float32) * lambda_k2[i].astype(jnp.float32)))
               + lam_init)
        sh_c, sc_c, ga_c = _modulation(c_ctx, w_ada[i], b_ada[i])
        q, k, v, g_att, cb, cc, ch, g_conv = _project(xp, sh_c, sc_c, norm_w[i], w_in[i],
                                                      q_norm_w[i], k_norm_w[i])
        new_k.append(k)
        new_v.append(v)
        att = _diff_attention(q, k, v, lam)
        xp = _finish(xp, att, g_att, cb, cc, ch, g_conv, ga_c, subln_w[i], conv_w[i], conv_b[i],
                     w_out[i], lam_init)
        sh, sc, ga = _modulation(c, w_ada[i], b_ada[i])
        q, k, v, g_att, cb, cc, ch, g_conv = _project(xs, sh[:, None], sc[:, None], norm_w[i],
                                                      w_in[i], q_norm_w[i], k_norm_w[i])
        q = _apply_axial_rope(q, rope)
        k = _apply_axial_rope(k, rope)
        k_all = jnp.concatenate([k, cache_k[:, i].astype(k.dtype)], axis=1)
        v_all = jnp.concatenate([v, cache_v[:, i].astype(v.dtype)], axis=1)
        att = _diff_attention(q, k_all, v_all, lam)
        xs = _finish(xs, att, g_att, cb, cc, ch, g_conv, ga[:, None], subln_w[i], conv_w[i],
                     conv_b[i], w_out[i], lam_init)
    new_cache_k = jnp.stack(new_k, axis=1)
    new_cache_v = jnp.stack(new_v, axis=1)
    return (xp, xs, new_cache_k, new_cache_v)
```

```cpp
#include <hip/hip_runtime.h>
#include <hip/hip_bf16.h>
#include <cstdio>
#include <cstdint>
#include <cmath>
namespace pg8 {
#define PG8_LAS __attribute__((address_space(3)))
typedef unsigned short bf16_t;
typedef short bf16x8 __attribute__((ext_vector_type(8)));
typedef float f32x4 __attribute__((ext_vector_type(4)));
typedef unsigned u32x4 __attribute__((ext_vector_type(4)));
constexpr int BM = 256, BK = 64, HALF = 128, HTB = HALF * BK * 2  , STAGE_BYTES = 8 * HTB, NXCD = 8, WGM = 8;

__host__ __device__ __forceinline__ int lds_byte(int r, int c) { const int st = (r >> 4) * 2 + (c >> 5), rr = r & 15, cc = c & 31, ob = rr * 64 + cc * 2; return st * 1024 + (ob ^ (((ob >> 9) & 1) << 5)); }
__host__ __device__ __forceinline__ void stage_rc(int b, int& R, int& C) { const int st = b / 1024, sb = b % 1024, swz = sb ^ (((sb >> 9) & 1) << 5); R = (st >> 1) * 16 + swz / 64; C = (st & 1) * 32 + (swz % 64) / 2; }
__host__ __device__ __forceinline__ int perm32(int rho) { const int n = rho >> 4, i = rho & 15; return 8 * (i >> 2) + 4 * n + (i & 3); }

struct Unit { int pm, pn; };
struct Gemm { const bf16_t* A; const bf16_t* Bt; int M, N, K; };

struct StaticOrder {
    int nM, nN, nwg, G, c;
    __host__ __device__ void init(int M, int N, int G_, int c_) { nM = M / BM; nN = N / BM; nwg = nM * nN; G = G_; c = c_; }
    __host__ __device__ bool next(int i, Unit& u) const {
        const long L = (long)i * G + c; if (L >= nwg) return false;
        int wgid = (int)L; { const int q = nwg / NXCD, r = nwg % NXCD, xcd = wgid % NXCD, off = wgid / NXCD; wgid = (xcd < r ? xcd * (q + 1) : r * (q + 1) + (xcd - r) * q) + off; }
        const int nig = WGM * nN, gid = wgid / nig, fm = gid * WGM, gsz = (nM - fm) < WGM ? (nM - fm) : WGM;
        u.pm = fm + ((wgid % nig) % gsz); u.pn = (wgid % nig) / gsz; return true;
    }
    __device__ __forceinline__ void a_ready(const Unit&) const {}
    __device__ __forceinline__ void done(const Unit&) const {}
};
template <class Epi, class Sched, bool ALIGN_EPI = false, bool SP2 = false>
__device__ __forceinline__ void gemm_phase(PG8_LAS unsigned char* lds, const Gemm g, const Sched& S, const Epi& E) {
    const int tid = threadIdx.x, wid = __builtin_amdgcn_readfirstlane(tid >> 6), lane = tid & 63, wr = wid >> 2, wc = wid & 3, fr = lane & 15, fq = lane >> 4;
    const int K = g.K, nt = K / BK;
    unsigned voffA[2], voffB[2];
#pragma unroll
    for (int i = 0; i < 2; ++i) { int R, C; stage_rc(tid * 16 + i * 8192, R, C); const int Rb = Epi::PERM ? ((R & ~31) + perm32(R & 31)) : R;
        voffA[i] = (unsigned)(R * K + C) * 2u; voffB[i] = (unsigned)(Rb * K + C) * 2u; }
    const size_t kstep = (size_t)(BK * 2);
    const size_t hstep = (size_t)HALF * K * 2;
    const size_t tstep = 2 * hstep;
    const unsigned ldsw = (unsigned)wid * 1024u;
    const int aoff = lds_byte(wr * 64 + fr, fq * 8), boff = lds_byte(wc * 32 + fr, fq * 8);
#define PG8_SA(b, h) (((b) * 2 + (h)) * HTB)
#define PG8_SB(b, h) ((4 + (b) * 2 + (h)) * HTB)
#define PG8_STAGE(bufoff, gbase, voff) do { _Pragma("unroll") for (int _i = 0; _i < 2; ++_i) \
        __builtin_amdgcn_global_load_lds((const unsigned*)((const char*)(gbase) + (voff)[_i]), (PG8_LAS unsigned*)(lds + (bufoff) + ldsw + _i * 8192), 16, 0, 0); } while (0)
#define PG8_LDA(dst, b, h) do { _Pragma("unroll") for (int m = 0; m < 4; ++m) _Pragma("unroll") for (int k = 0; k < 2; ++k) dst[m][k] = *(const PG8_LAS bf16x8*)(lds + PG8_SA(b, h) + aoff + m * 2048 + k * 1024); } while (0)
#define PG8_LDB(dst, b, h) do { _Pragma("unroll") for (int n = 0; n < 2; ++n) _Pragma("unroll") for (int k = 0; k < 2; ++k) dst[n][k] = *(const PG8_LAS bf16x8*)(lds + PG8_SB(b, h) + boff + n * 2048 + k * 1024); } while (0)
#define PG8_MMA(ai, bj, At, Bt) do { __builtin_amdgcn_s_setprio(1); _Pragma("unroll") for (int m = 0; m < 4; ++m) _Pragma("unroll") for (int n = 0; n < 2; ++n) _Pragma("unroll") for (int k = 0; k < 2; ++k) \
        acc[ai][bj][m][n] = __builtin_amdgcn_mfma_f32_16x16x32_bf16(Bt[n][k], At[m][k], acc[ai][bj][m][n], 0, 0, 0); __builtin_amdgcn_s_setprio(0); } while (0)
#define PG8_WAIT_V(n) asm volatile("s_waitcnt vmcnt(" #n ")" ::: "memory")
#define PG8_WAIT_L(n) asm volatile("s_waitcnt lgkmcnt(" #n ")" ::: "memory")
#define PG8_BAR __builtin_amdgcn_s_barrier()
#define PG8_SCHED __builtin_amdgcn_sched_barrier(0)
    Unit cur, nxt; int ui = 0;
    if (!S.next(0, cur)) return;
    f32x4 acc[2][2][4][2];
#pragma unroll
    for (int a = 0; a < 2; ++a)
#pragma unroll
        for (int b = 0; b < 2; ++b)
#pragma unroll
            for (int m = 0; m < 4; ++m)
#pragma unroll
                for (int n = 0; n < 2; ++n) acc[a][b][m][n] = (f32x4){0.f, 0.f, 0.f, 0.f};
    bf16x8 At[4][2], B0[2][2], B1[2][2];
    const char* cA = (const char*)g.A + (size_t)cur.pm * tstep; const char* cB = (const char*)g.Bt + (size_t)cur.pn * tstep;
    S.a_ready(cur);
    if constexpr (SP2) {
        PG8_STAGE(PG8_SB(0, 0), cB, voffB); PG8_STAGE(PG8_SB(0, 1), cB + hstep, voffB); PG8_STAGE(PG8_SA(0, 0), cA, voffA); PG8_STAGE(PG8_SA(0, 1), cA + hstep, voffA);
        if (wr == 1) PG8_BAR;
        PG8_WAIT_V(2); PG8_BAR;
        PG8_STAGE(PG8_SB(1, 0), cB + kstep, voffB); PG8_STAGE(PG8_SA(1, 0), cA + kstep, voffA); PG8_STAGE(PG8_SB(1, 1), cB + hstep + kstep, voffB);
        PG8_WAIT_V(6); PG8_BAR;
    } else {
        PG8_STAGE(PG8_SB(0, 0), cB, voffB); PG8_STAGE(PG8_SA(0, 0), cA, voffA); PG8_STAGE(PG8_SB(0, 1), cB + hstep, voffB); PG8_STAGE(PG8_SA(0, 1), cA + hstep, voffA);
        if (wr == 1) PG8_BAR;
        PG8_WAIT_V(4); PG8_BAR;
        PG8_STAGE(PG8_SB(1, 0), cB + kstep, voffB); PG8_STAGE(PG8_SA(1, 0), cA + kstep, voffA); PG8_STAGE(PG8_SB(1, 1), cB + hstep + kstep, voffB);
        PG8_WAIT_V(6); PG8_BAR;
    }
    for (;;) {
        const bool has_next = S.next(ui + 1, nxt);
        const char* nA = has_next ? (const char*)g.A + (size_t)nxt.pm * tstep : cA; const char* nB = has_next ? (const char*)g.Bt + (size_t)nxt.pn * tstep : cB;
        for (int t = 0; t < nt; t += 2) {
            const bool last = (t == nt - 2);
            const char* a1 = cA + (size_t)(t + 1) * kstep;
            const char* a2 = last ? nA : cA + (size_t)(t + 2) * kstep; const char* b2 = last ? nB : cB + (size_t)(t + 2) * kstep;
            const char* a3 = a2 + kstep; const char* b3 = b2 + kstep;
            if (last && has_next) S.a_ready(nxt);
            if constexpr (SP2) {
            PG8_LDB(B0, 0, 0); PG8_LDB(B1, 0, 1); PG8_SCHED; PG8_LDA(At, 0, 0); PG8_STAGE(PG8_SA(1, 1), a1 + hstep, voffA);
            PG8_WAIT_V(8); PG8_WAIT_L(0); PG8_BAR; PG8_MMA(0, 0, At, B0); PG8_MMA(0, 1, At, B1); PG8_BAR; PG8_SCHED;
            PG8_LDA(At, 0, 1); PG8_STAGE(PG8_SB(0, 0), b2, voffB); PG8_STAGE(PG8_SB(0, 1), b2 + hstep, voffB); PG8_STAGE(PG8_SA(0, 0), a2, voffA);
            PG8_WAIT_V(8); PG8_WAIT_L(0); PG8_BAR; PG8_MMA(1, 0, At, B0); PG8_MMA(1, 1, At, B1); PG8_BAR; PG8_SCHED;
            PG8_LDB(B0, 1, 0); PG8_LDB(B1, 1, 1); PG8_SCHED; PG8_LDA(At, 1, 0); PG8_STAGE(PG8_SA(0, 1), a2 + hstep, voffA);
            PG8_WAIT_V(8); PG8_WAIT_L(0); PG8_BAR; PG8_MMA(0, 0, At, B0); PG8_MMA(0, 1, At, B1); PG8_BAR; PG8_SCHED;
            PG8_LDA(At, 1, 1); PG8_STAGE(PG8_SB(1, 0), b3, voffB); PG8_STAGE(PG8_SB(1, 1), b3 + hstep, voffB); PG8_STAGE(PG8_SA(1, 0), a3, voffA);
            PG8_WAIT_V(8); PG8_WAIT_L(0); PG8_BAR; PG8_MMA(1, 0, At, B0); PG8_MMA(1, 1, At, B1); PG8_BAR; PG8_SCHED;
            } else {
            PG8_LDB(B0, 0, 0); PG8_SCHED; PG8_LDA(At, 0, 0); PG8_STAGE(PG8_SA(1, 1), a1 + hstep, voffA);
            PG8_WAIT_L(8); PG8_BAR; PG8_WAIT_L(0); PG8_MMA(0, 0, At, B0); PG8_BAR; PG8_SCHED;
            PG8_LDB(B1, 0, 1); PG8_STAGE(PG8_SB(0, 0), b2, voffB);
            PG8_BAR; PG8_WAIT_L(0); PG8_MMA(0, 1, At, B1); PG8_BAR;
            PG8_LDA(At, 0, 1); PG8_STAGE(PG8_SA(0, 0), a2, voffA);
            PG8_BAR; PG8_WAIT_L(0); PG8_MMA(1, 0, At, B0); PG8_BAR; PG8_SCHED;
            PG8_STAGE(PG8_SB(0, 1), b2 + hstep, voffB);
            PG8_WAIT_V(6); PG8_BAR; PG8_MMA(1, 1, At, B1); PG8_BAR;
            PG8_LDB(B0, 1, 0); PG8_SCHED; PG8_LDA(At, 1, 0); PG8_STAGE(PG8_SA(0, 1), a2 + hstep, voffA);
            PG8_WAIT_L(8); PG8_BAR; PG8_WAIT_L(0); PG8_MMA(0, 0, At, B0); PG8_BAR; PG8_SCHED;
            PG8_LDB(B1, 1, 1); PG8_STAGE(PG8_SB(1, 0), b3, voffB);
            PG8_BAR; PG8_WAIT_L(0); PG8_MMA(0, 1, At, B1); PG8_BAR;
            PG8_LDA(At, 1, 1); PG8_STAGE(PG8_SA(1, 0), a3, voffA);
            PG8_BAR; PG8_WAIT_L(0); PG8_MMA(1, 0, At, B0); PG8_BAR; PG8_SCHED;
            PG8_STAGE(PG8_SB(1, 1), b3 + hstep, voffB);
            PG8_WAIT_V(6); PG8_BAR; PG8_MMA(1, 1, At, B1); PG8_BAR;
            }
        }
        if constexpr (ALIGN_EPI) { if (wr == 0) PG8_BAR; }
        if constexpr (!Epi::AFTER_DRAIN) { E(acc, cur, wr, wc, fr, fq); S.done(cur); }
        if (!has_next) break;
#pragma unroll
        for (int a = 0; a < 2; ++a)
#pragma unroll
            for (int b = 0; b < 2; ++b)
#pragma unroll
                for (int m = 0; m < 4; ++m)
#pragma unroll
                    for (int n = 0; n < 2; ++n) acc[a][b][m][n] = (f32x4){0.f, 0.f, 0.f, 0.f};
        cur = nxt; cA = nA; cB = nB; ++ui;
        if constexpr (ALIGN_EPI) { if (wr == 1) PG8_BAR; }
    }
    PG8_WAIT_V(0);
    if constexpr (!ALIGN_EPI) { if (wr == 0) PG8_BAR; }
    PG8_BAR;
    if constexpr (Epi::AFTER_DRAIN) { E.fused(acc, cur, wr, wc, fr, fq, lds, wid, lane); S.done(cur); }
#undef PG8_SA
#undef PG8_SB
#undef PG8_STAGE
#undef PG8_LDA
#undef PG8_LDB
#undef PG8_MMA
#undef PG8_WAIT_V
#undef PG8_WAIT_L
#undef PG8_BAR
#undef PG8_SCHED
}
}

constexpr int DM = 1024, DIN = 4096, NCTXB = 16, SEQC = 256, NLATB = 8, SEQL = 4096, PAST = 256;
constexpr int MC = NCTXB * SEQC;
constexpr int ML = NLATB * SEQL;
constexpr int MROWS = MC + ML;
constexpr int KVL = SEQL + PAST;
constexpr int KVROWS = MC + NLATB * KVL;
constexpr int DH = 512;
constexpr float RMS_EPS = 1e-6f;
constexpr float LAM_INIT = 0.2f;
constexpr float QC2 = 0.125f * 1.4426950408889634f;
__host__ __device__ __forceinline__ int krow_of(int row) { return row < MC ? row : MC + ((row - MC) >> 12) * KVL + ((row - MC) & (SEQL - 1)); }

namespace pg8 {
typedef unsigned u32x2 __attribute__((ext_vector_type(2)));
__device__ __forceinline__ unsigned cvt_pk_bf16(float lo, float hi) { unsigned r; asm volatile("v_cvt_pk_bf16_f32 %0, %1, %2" : "=v"(r) : "v"(lo), "v"(hi)); return r; }
__device__ __forceinline__ float silu_f(float v) { return v * __builtin_amdgcn_rcpf(1.0f + __builtin_amdgcn_exp2f(-1.4426950408889634f * v)); }
__device__ __forceinline__ f32x4 silu4(f32x4 v) { return (f32x4){silu_f(v[0]), silu_f(v[1]), silu_f(v[2]), silu_f(v[3])}; }
__device__ __forceinline__ u32x4 pack8(f32x4 a, f32x4 b) { u32x4 w; w.x = cvt_pk_bf16(a[0], a[1]); w.y = cvt_pk_bf16(a[2], a[3]); w.z = cvt_pk_bf16(b[0], b[1]); w.w = cvt_pk_bf16(b[2], b[3]); return w; }

struct EpiProj {
    static constexpr bool PERM = false, AFTER_DRAIN = false;
    bf16_t *Q, *Kb, *Vb, *GA, *U, *CBG; float *nck, *ncv; const float *qnw, *knw, *ropec, *ropes;
    __device__ __forceinline__ void operator()(const f32x4 (&acc)[2][2][4][2], const Unit& u, int wr, int wc, int fr, int fq) const {
        const int pn = u.pn, pm = u.pm; const bool lat = pm >= (MC / 256);
        const int rbase = pm * BM + wr * 64 + fr;
        if (pn < 4) {
            const bool isk = pn >= 2; const int g = 4 * (pn & 1) + wc, dbase = 32 * (fq >> 1) + 8 * (fq & 1);
            const float* nw = isk ? knw : qnw; const float sc = isk ? 1.0f : QC2;
            f32x4 w[2][2];
#pragma unroll
            for (int bj = 0; bj < 2; ++bj)
#pragma unroll
                for (int n = 0; n < 2; ++n) w[bj][n] = *(const f32x4*)(nw + dbase + 16 * bj + 4 * n);
#pragma unroll
            for (int ai = 0; ai < 2; ++ai)
#pragma unroll
                for (int m = 0; m < 4; ++m) {
                    const int row = rbase + ai * HALF + m * 16;
                    f32x4 v[2][2]; float ss = 0.f;
#pragma unroll
                    for (int bj = 0; bj < 2; ++bj)
#pragma unroll
                        for (int n = 0; n < 2; ++n) { v[bj][n] = acc[ai][bj][m][n]; const f32x4 q = v[bj][n] * v[bj][n]; ss += (q[0] + q[1]) + (q[2] + q[3]); }
                    ss += __shfl_xor(ss, 16); ss += __shfl_xor(ss, 32);
                    const float rstd = 1.0f / sqrtf(ss * (1.0f / 64.0f) + RMS_EPS);
#pragma unroll
                    for (int bj = 0; bj < 2; ++bj)
#pragma unroll
                        for (int n = 0; n < 2; ++n) v[bj][n] = (v[bj][n] * rstd) * w[bj][n];
                    if (lat) {
                        const int t = (row - MC) & (SEQL - 1), p = (fq >> 1) ? (t & 63) : (t >> 6);
                        const float* cp = ropec + p * 16 + 8 * (fq & 1); const float* sp = ropes + p * 16 + 8 * (fq & 1);
#pragma unroll
                        for (int n = 0; n < 2; ++n) { const f32x4 c4 = *(const f32x4*)(cp + 4 * n), s4 = *(const f32x4*)(sp + 4 * n), x1 = v[0][n], x2 = v[1][n];
                            v[0][n] = x1 * c4 - x2 * s4; v[1][n] = x2 * c4 + x1 * s4; }
                    }
                    bf16_t* dst = (isk ? Kb + (size_t)krow_of(row) * DH : Q + (size_t)row * DH) + g * 64 + dbase;
#pragma unroll
                    for (int bj = 0; bj < 2; ++bj) *(u32x4*)(dst + 16 * bj) = pack8(v[bj][0] * sc, v[bj][1] * sc);
                    if (isk && !lat) { float* o = nck + (size_t)row * DH + g * 64 + dbase;
#pragma unroll
                        for (int bj = 0; bj < 2; ++bj) { *(f32x4*)(o + 16 * bj) = v[bj][0]; *(f32x4*)(o + 16 * bj + 4) = v[bj][1]; } }
                }
        } else if (pn < 8) {
            const bool isg = pn >= 6; const int cbase = 256 * (pn & 1) + 32 * wc + 8 * fq;
#pragma unroll
            for (int ai = 0; ai < 2; ++ai)
#pragma unroll
                for (int m = 0; m < 4; ++m) {
                    const int row = rbase + ai * HALF + m * 16;
                    bf16_t* dst = (isg ? GA + (size_t)row * DH : Vb + (size_t)krow_of(row) * DH) + cbase;
#pragma unroll
                    for (int bj = 0; bj < 2; ++bj) { f32x4 a = acc[ai][bj][m][0], b = acc[ai][bj][m][1];
                        if (!isg && !lat) { float* o = ncv + (size_t)row * DH + cbase + 128 * bj; *(f32x4*)o = a; *(f32x4*)(o + 4) = b; }
                        if (isg) { a = silu4(a); b = silu4(b); }
                        *(u32x4*)(dst + 128 * bj) = pack8(a, b); }
                }
        } else {
            const int ch0 = 64 * (pn - 8) + 16 * wc + 4 * fq;
#pragma unroll
            for (int ai = 0; ai < 2; ++ai)
#pragma unroll
                for (int m = 0; m < 4; ++m) {
                    const int row = rbase + ai * HALF + m * 16;
                    const f32x4 cb = acc[ai][0][m][0], cc = acc[ai][0][m][1], chh = acc[ai][1][m][0], gc = acc[ai][1][m][1];
                    const f32x4 uu = cc * chh, cg = cb * silu4(gc);
                    u32x2 a, b; a.x = cvt_pk_bf16(uu[0], uu[1]); a.y = cvt_pk_bf16(uu[2], uu[3]); b.x = cvt_pk_bf16(cg[0], cg[1]); b.y = cvt_pk_bf16(cg[2], cg[3]);
                    *(u32x2*)(U + (size_t)row * DH + ch0) = a; *(u32x2*)(CBG + (size_t)row * DH + ch0) = b;
                }
        }
    }
};
__host__ __device__ __forceinline__ int win_dest_row(int s) {
    if (s < 1024) { const int sp = s >> 9, g = (s >> 6) & 7, d = s & 63, t = g >> 2, wc = g & 3;
        const int fqh = d >> 5, bj = (d >> 4) & 1, fql = (d >> 3) & 1, n = (d >> 2) & 1, e = d & 3, fq = 2 * fqh + fql;
        return 256 * (2 * sp + t) + 128 * bj + 32 * wc + 16 * n + 4 * fq + e; }
    if (s < 2048) { const int c = s & 255, pn = s >> 8, bj = c >> 7, wc = (c >> 5) & 3, fq = (c >> 3) & 3, n = (c >> 2) & 1, e = c & 3;
        return 256 * pn + 128 * bj + 32 * wc + 16 * n + 4 * fq + e; }
    { const int role = (s - 2048) >> 9, ch = s & 511, j = ch >> 6, wc = (ch >> 4) & 3, fq = (ch >> 2) & 3, e = ch & 3, bj = role >> 1, n = role & 1;
        return 256 * (8 + j) + 128 * bj + 32 * wc + 16 * n + 4 * fq + e; }
}
struct EpiOut {
    static constexpr bool PERM = false, AFTER_DRAIN = false;
    const float *xp, *xs, *gate; float* out;
    __device__ __forceinline__ void operator()(const f32x4 (&acc)[2][2][4][2], const Unit& u, int wr, int wc, int fr, int fq) const {
        const int pm = u.pm, mb = pm < (MC / 256) ? 0 : 1 + ((pm - MC / 256) >> 4);
        const int col0 = u.pn * BM + wc * 32 + 4 * fq, rbase = pm * BM + wr * 64 + fr;
        f32x4 g4[2][2];
#pragma unroll
        for (int bj = 0; bj < 2; ++bj)
#pragma unroll
            for (int n = 0; n < 2; ++n) g4[bj][n] = *(const f32x4*)(gate + mb * DM + col0 + bj * HALF + n * 16);
#pragma unroll
        for (int ai = 0; ai < 2; ++ai)
#pragma unroll
            for (int m = 0; m < 4; ++m) {
                const int row = rbase + ai * HALF + m * 16;
                const float* xr = (row < MC ? xp + (size_t)row * DM : xs + (size_t)(row - MC) * DM) + col0; float* orow = out + (size_t)row * DM + col0;
#pragma unroll
                for (int bj = 0; bj < 2; ++bj)
#pragma unroll
                    for (int n = 0; n < 2; ++n) { const f32x4 x4 = *(const f32x4*)(xr + bj * HALF + n * 16); *(f32x4*)(orow + bj * HALF + n * 16) = x4 + g4[bj][n] * acc[ai][bj][m][n]; }
            }
    }
};
}

namespace att {
typedef unsigned short bf16_t;
using bf16x8 = __attribute__((ext_vector_type(8))) short;
using s16x4  = __attribute__((ext_vector_type(4))) short;
using f32x16 = __attribute__((ext_vector_type(16))) float;
using f32x4  = __attribute__((ext_vector_type(4))) float;
using u32x4  = __attribute__((ext_vector_type(4))) unsigned;
constexpr int NW = 8, KVBLK = 64, LDK = DH;
constexpr int SHM_V = KVBLK * 128 * 2, SHM_K = KVBLK * 128 * 2;
constexpr int OL_PITCH = 132;
constexpr int OFF_V = 0, OFF_K = 2 * SHM_V, OFF_WS = 128 * OL_PITCH * 4, ATT_LDS_BYTES = OFF_WS + NW * 64 * 4;
static_assert(OFF_WS >= 2 * SHM_V + 2 * SHM_K, "per-wave scratch above the K/V buffers");
#define KSWZ(row, colB) ((row) * 256 + ((colB) ^ (((row) & 15) << 4)))
#define SBAR() __builtin_amdgcn_sched_barrier(0)
__device__ __forceinline__ int crow(int r, int hi) { return (r & 3) + 8 * (r >> 2) + 4 * hi; }
__device__ __forceinline__ unsigned cvtpk(float lo, float hi) { unsigned r; asm volatile("v_cvt_pk_bf16_f32 %0, %1, %2" : "=v"(r) : "v"(lo), "v"(hi)); return r; }
__device__ __forceinline__ void exp_half(f32x16& p) {
#pragma unroll
  for (int r = 0; r < 16; ++r) p[r] = __builtin_amdgcn_exp2f(p[r]);
}
__device__ __forceinline__ void finishSM(f32x16& p0, f32x16& p1, float& l_reg, bf16x8& pa0, bf16x8& pa1, bf16x8& pa2, bf16x8& pa3) {
  exp_half(p1);
  float ps = 0;
#pragma unroll
  for (int r = 0; r < 16; ++r) ps += p0[r];
#pragma unroll
  for (int r = 0; r < 16; ++r) ps += p1[r];
  l_reg += ps;
#define PK4(P, BASE, OUT) do { unsigned a0 = cvtpk(P[BASE + 0], P[BASE + 1]), a1 = cvtpk(P[BASE + 2], P[BASE + 3]);   \
    unsigned b0 = cvtpk(P[BASE + 4], P[BASE + 5]), b1 = cvtpk(P[BASE + 6], P[BASE + 7]);                              \
    auto r0 = __builtin_amdgcn_permlane32_swap(a0, b0, false, false); auto r1 = __builtin_amdgcn_permlane32_swap(a1, b1, false, false); \
    u32x4 w = {r0[0], r1[0], r0[1], r1[1]}; OUT = *reinterpret_cast<bf16x8*>(&w); } while (0)
  PK4(p0, 0, pa0); PK4(p0, 8, pa1); PK4(p1, 0, pa2); PK4(p1, 8, pa3);
#undef PK4
}
__device__ __forceinline__ void qkt(f32x16& p0, f32x16& p1, const char* Ks, const bf16x8* qr, int r32, int hi, int kc0) {
  p0 = f32x16{}; p1 = f32x16{};
#pragma unroll
  for (int d0 = 0; d0 < 4; ++d0) { const int cb = kc0 + (d0 * 16 + hi * 8) * 2;
    const bf16x8 b0 = *reinterpret_cast<const bf16x8*>(Ks + KSWZ(r32, cb));
    const bf16x8 b1 = *reinterpret_cast<const bf16x8*>(Ks + KSWZ(32 + r32, cb));
    p0 = __builtin_amdgcn_mfma_f32_32x32x16_bf16(b0, qr[d0], p0, 0, 0, 0);
    p1 = __builtin_amdgcn_mfma_f32_32x32x16_bf16(b1, qr[d0], p1, 0, 0, 0); }
}
__device__ __forceinline__ int v_st(int k, int c) { const int kk = (k & ~0xC) | ((k & 4) << 1) | ((k & 8) >> 1); return ((kk >> 3) * 4 + (c >> 5)) * 512 + ((kk & 7) * 32 + (c & 31)) * 2; }
__device__ __forceinline__ int v_rd_base(int lane) { return ((lane & 3) << 3) | (((lane >> 2) & 3) << 6) | (((lane >> 4) & 1) << 5) | (((lane >> 5) & 1) << 8); }
constexpr int v_rd_off(int d0, int ks, int half) { return d0 * 512 + ks * 4096 + half * 2048; }
template <int OFF> __device__ __forceinline__ s16x4 tr_read(int vb) {
  s16x4 r; asm volatile("ds_read_b64_tr_b16 %0, %1 offset:%2" : "=&v"(r) : "v"(vb), "i"(OFF) : "memory"); return r;
}
template <int D0> __device__ __forceinline__ void pv_one(f32x16& od, int vb, bf16x8 pa0, bf16x8 pa1, bf16x8 pa2, bf16x8 pa3) {
  const s16x4 l0 = tr_read<v_rd_off(D0, 0, 0)>(vb), h0 = tr_read<v_rd_off(D0, 0, 1)>(vb), l1 = tr_read<v_rd_off(D0, 1, 0)>(vb), h1 = tr_read<v_rd_off(D0, 1, 1)>(vb);
  const s16x4 l2 = tr_read<v_rd_off(D0, 2, 0)>(vb), h2 = tr_read<v_rd_off(D0, 2, 1)>(vb), l3 = tr_read<v_rd_off(D0, 3, 0)>(vb), h3 = tr_read<v_rd_off(D0, 3, 1)>(vb);
  asm volatile("s_waitcnt lgkmcnt(0)" ::: "memory"); SBAR();
#define PK(L, H) (bf16x8){L[0], L[1], L[2], L[3], H[0], H[1], H[2], H[3]}
  od = __builtin_amdgcn_mfma_f32_32x32x16_bf16(pa0, PK(l0, h0), od, 0, 0, 0);
  od = __builtin_amdgcn_mfma_f32_32x32x16_bf16(pa1, PK(l1, h1), od, 0, 0, 0);
  od = __builtin_amdgcn_mfma_f32_32x32x16_bf16(pa2, PK(l2, h2), od, 0, 0, 0);
  od = __builtin_amdgcn_mfma_f32_32x32x16_bf16(pa3, PK(l3, h3), od, 0, 0, 0);
#undef PK
}
__device__ __forceinline__ void pv_d0(f32x16* o, int vb, bf16x8 pa0, bf16x8 pa1, bf16x8 pa2, bf16x8 pa3) {
  pv_one<0>(o[0], vb, pa0, pa1, pa2, pa3); pv_one<1>(o[1], vb, pa0, pa1, pa2, pa3); pv_one<2>(o[2], vb, pa0, pa1, pa2, pa3); pv_one<3>(o[3], vb, pa0, pa1, pa2, pa3);
}
__device__ __forceinline__ void attn_unit(const bf16_t* __restrict__ Qb, const bf16_t* __restrict__ Kh, const bf16_t* __restrict__ Vh, const bf16_t* __restrict__ GAb,
                                          bf16_t* __restrict__ MIXb, int seq, float lam, const float* __restrict__ subw, char* lds) {
  const int tid = threadIdx.x, wid = tid >> 6, lane = tid & 63, r32 = lane & 31, hi = lane >> 5, mp = wid >> 2, qb = wid & 3;
  char* V_lds = lds + OFF_V; char* K_lds = lds + OFF_K;
  float* ws = (float*)(lds + OFF_WS) + wid * 64;
  float l_reg = 0; f32x16 o[4] = {}; bf16x8 qr[4];
  const bf16_t* Qw = Qb + (long)(qb * 32 + r32) * DH + mp * 64 + hi * 8;
#pragma unroll
  for (int d0 = 0; d0 < 4; ++d0) qr[d0] = *reinterpret_cast<const bf16x8*>(Qw + d0 * 16);
  const int kc0 = mp * 128;
  const int sr = tid >> 4, sc = (tid & 15) * 8, vst0 = v_st(sr, sc), vst1 = v_st(32 + sr, sc);
  const int vb0 = (int)(uintptr_t)V_lds + v_rd_base(lane);
  struct { bf16x8 vs0, vs1, ks0, ks1; } sr_[2];
#define SLOAD(i, k0) do { sr_[i].vs0 = *reinterpret_cast<const bf16x8*>(&Vh[(long)((k0) + sr) * LDK + sc]); sr_[i].vs1 = *reinterpret_cast<const bf16x8*>(&Vh[(long)((k0) + 32 + sr) * LDK + sc]); \
    sr_[i].ks0 = *reinterpret_cast<const bf16x8*>(&Kh[(long)((k0) + sr) * LDK + sc]); sr_[i].ks1 = *reinterpret_cast<const bf16x8*>(&Kh[(long)((k0) + 32 + sr) * LDK + sc]); } while (0)
#define SWRITE(b, i) do { *(bf16x8*)(V_lds + (b) * SHM_V + vst0) = sr_[i].vs0;          \
    *(bf16x8*)(V_lds + (b) * SHM_V + vst1) = sr_[i].vs1; const int kc = sc * 2;               \
    *(bf16x8*)(K_lds + (b) * SHM_K + KSWZ(sr, kc)) = sr_[i].ks0;                       \
    *(bf16x8*)(K_lds + (b) * SHM_K + KSWZ(32 + sr, kc)) = sr_[i].ks1; } while (0)
#define SWAIT() asm volatile("s_waitcnt vmcnt(4)" ::: "memory")
  f32x16 pA0, pA1, pB0, pB1; bf16x8 pa0, pa1, pa2, pa3; const int NT = seq / KVBLK;
  constexpr int SE = 0, SO = 1;
  __syncthreads();
  SLOAD(SE, 0); asm volatile("s_waitcnt vmcnt(0)" ::: "memory"); SWRITE(0, SE); __syncthreads();
  qkt(pA0, pA1, K_lds, qr, r32, hi, kc0); exp_half(pA0);
  SLOAD(SO, KVBLK); if (2 < NT) SLOAD(SE, 2 * KVBLK);
  SWAIT(); SWRITE(1, SO); __syncthreads();
  for (int j = 1; j + 1 < NT; j += 2) {
    SBAR(); qkt(pB0, pB1, K_lds + SHM_K, qr, r32, hi, kc0);
    finishSM(pA0, pA1, l_reg, pa0, pa1, pa2, pa3); SBAR();
    SLOAD(SO, (j + 2) * KVBLK); SBAR();
    pv_d0(o, vb0, pa0, pa1, pa2, pa3); exp_half(pB0);
    __syncthreads(); SWAIT(); SWRITE(0, SE);
    __syncthreads();
    SBAR(); qkt(pA0, pA1, K_lds, qr, r32, hi, kc0);
    finishSM(pB0, pB1, l_reg, pa0, pa1, pa2, pa3); SBAR();
    if (j + 3 < NT) SLOAD(SE, (j + 3) * KVBLK); SBAR();
    pv_d0(o, vb0 + SHM_V, pa0, pa1, pa2, pa3); exp_half(pA0);
    __syncthreads(); SWAIT(); SWRITE(1, SO);
    __syncthreads();
  }
  SBAR(); qkt(pB0, pB1, K_lds + SHM_K, qr, r32, hi, kc0);
  finishSM(pA0, pA1, l_reg, pa0, pa1, pa2, pa3); SBAR();
  pv_d0(o, vb0, pa0, pa1, pa2, pa3); exp_half(pB0);
  finishSM(pB0, pB1, l_reg, pa0, pa1, pa2, pa3); SBAR();
  pv_d0(o, vb0 + SHM_V, pa0, pa1, pa2, pa3);
#undef SLOAD
#undef SWRITE
#undef SWAIT
  int tid_e = tid; asm volatile("" : "+v"(tid_e));
  const int lane_e = tid_e & 63, r32e = lane_e & 31, hie = lane_e >> 5, wide = tid_e >> 6, mpe = wide >> 2, qbe = wide & 3;
  { auto rr = __builtin_amdgcn_permlane32_swap(__float_as_uint(l_reg), __float_as_uint(l_reg), false, false); l_reg = __uint_as_float(rr[0]) + __uint_as_float(rr[1]); }
  float* wse = (float*)(lds + OFF_WS) + wide * 64;
  if (hie == 0) wse[r32e] = l_reg;
  asm volatile("s_waitcnt lgkmcnt(0)" ::: "memory");
  float rli[16];
#pragma unroll
  for (int r = 0; r < 16; ++r) rli[r] = __builtin_amdgcn_rcpf(wse[crow(r, hie)]);
  float* OL = (float*)lds;
  __syncthreads();
  if (mpe == 1) {
#pragma unroll
    for (int r = 0; r < 16; ++r) { const int row = qbe * 32 + crow(r, hie); const float f = lam * rli[r];
#pragma unroll
      for (int d0 = 0; d0 < 4; ++d0) OL[row * OL_PITCH + d0 * 32 + r32e] = o[d0][r] * f; }
  }
  __syncthreads();
  if (mpe == 0) {
#pragma unroll
    for (int r = 0; r < 16; ++r) { const int row = qbe * 32 + crow(r, hie);
#pragma unroll
      for (int d0 = 0; d0 < 4; ++d0) { float* p = OL + row * OL_PITCH + d0 * 32 + r32e; *p = o[d0][r] * rli[r] - *p; } }
  }
  __syncthreads();
  { const int row = tid_e >> 2, q = tid_e & 3; const float* src = OL + row * OL_PITCH + q * 32;
    f32x4 a[8]; float ss = 0.f;
#pragma unroll
    for (int i = 0; i < 8; ++i) { a[i] = *(const f32x4*)(src + 4 * i); const f32x4 s2 = a[i] * a[i]; ss += (s2[0] + s2[1]) + (s2[2] + s2[3]); }
    ss += __shfl_xor(ss, 1); ss += __shfl_xor(ss, 2);
    const float rs = (1.0f - LAM_INIT) / sqrtf(ss * (1.0f / 128.0f) + RMS_EPS);
    const bf16_t* gp = GAb + (long)row * DH + q * 32; bf16_t* mpo = MIXb + (long)row * DM + q * 32; const float* wp = subw + q * 32;
#pragma unroll
    for (int i = 0; i < 4; ++i) { const u32x4 gv = *(const u32x4*)(gp + 8 * i); const f32x4 w0 = *(const f32x4*)(wp + 8 * i), w1 = *(const f32x4*)(wp + 8 * i + 4);
      const f32x4 x0 = a[2 * i] * rs * w0, x1 = a[2 * i + 1] * rs * w1;
      f32x4 g0, g1; g0[0] = __uint_as_float(gv.x << 16); g0[1] = __uint_as_float(gv.x & 0xffff0000u); g0[2] = __uint_as_float(gv.y << 16); g0[3] = __uint_as_float(gv.y & 0xffff0000u);
      g1[0] = __uint_as_float(gv.z << 16); g1[1] = __uint_as_float(gv.z & 0xffff0000u); g1[2] = __uint_as_float(gv.w << 16); g1[3] = __uint_as_float(gv.w & 0xffff0000u);
      const f32x4 y0 = x0 * g0, y1 = x1 * g1; u32x4 w; w.x = cvtpk(y0[0], y0[1]); w.y = cvtpk(y0[2], y0[3]); w.z = cvtpk(y1[0], y1[1]); w.w = cvtpk(y1[2], y1[3]);
      *(u32x4*)(mpo + 8 * i) = w; }
  }
}
#undef KSWZ
#undef SBAR
}
#define GAS __attribute__((address_space(1)))
#define LAS __attribute__((address_space(3)))
typedef unsigned short bf16;
typedef unsigned v4u __attribute__((ext_vector_type(4)));
typedef float f32x4 __attribute__((ext_vector_type(4)));
typedef short bf16x8 __attribute__((ext_vector_type(8)));
typedef GAS unsigned gu32;
typedef GAS unsigned long long gu64;
#define RLX_AGENT __ATOMIC_RELAXED, __HIP_MEMORY_SCOPE_AGENT
#define LDS_WAIT() asm volatile("s_waitcnt lgkmcnt(0)" ::: "memory")
#define VM_WAIT() asm volatile("s_waitcnt vmcnt(0)" ::: "memory")
__device__ __forceinline__ unsigned long long rt() { return __builtin_amdgcn_s_memrealtime(); }
__device__ __forceinline__ unsigned f2bf(float f) { unsigned u = __builtin_bit_cast(unsigned, f); return (u + 0x7fffu + ((u >> 16) & 1u)) >> 16; }
__device__ __forceinline__ unsigned pk2(float lo, float hi) { return f2bf(lo) | (f2bf(hi) << 16); }

#define XB_TMO      128
#define XB_XCNT(j)  (256  + 64 * (j))
#define XB_XSUB(j)  (1280 + 64 * (j))
#define XB_XGEN(j)  (2304 + 64 * (j))
#define XB_TOP      3328
#define XB_TOPGEN   3392
#define XCD_BAR_WORDS 3456
#define XB_SPIN_CAP (1u << 18)

__device__ __forceinline__ unsigned xb_ld(unsigned* p)              { return __hip_atomic_load(p, __ATOMIC_RELAXED, __HIP_MEMORY_SCOPE_AGENT); }
__device__ __forceinline__ unsigned xb_add(unsigned* p, unsigned v) { return __hip_atomic_fetch_add(p, v, __ATOMIC_RELAXED, __HIP_MEMORY_SCOPE_AGENT); }
__device__ __forceinline__ unsigned xb_xcc_id() { return (unsigned)__builtin_amdgcn_s_getreg((3 << 11) | 20) & 0xFu; }
#define XB_SPIN(cond, bar) do { unsigned _sp = 0; while (cond) { __builtin_amdgcn_s_sleep(1); \
    if ((++_sp & 255u) == 0u) { if (xb_ld(&(bar)[XB_TMO])) break; if (_sp > XB_SPIN_CAP) { atomicAdd(&(bar)[XB_TMO], 1u); break; } } } } while (0)

struct XcdBarrier {
    unsigned* bar; unsigned x;
    volatile LAS unsigned* st;
};

__device__ __forceinline__ XcdBarrier xcd_barrier_post(unsigned* bar, volatile LAS unsigned* st) {
    XcdBarrier b; b.bar = bar; b.x = xb_xcc_id(); b.st = st;
    if (threadIdx.x == 0) (void)xb_add(&bar[XB_XCNT(b.x)], 1u);
    return b;
}
__device__ __forceinline__ void xcd_barrier_complete(unsigned* bar, unsigned x, unsigned& nloc, unsigned& nx) {
    const unsigned G = gridDim.x * gridDim.y * gridDim.z;
    unsigned sum, cnt, mine, sp = 0u;
    for (;;) {
        sum = 0u; cnt = 0u; mine = 0u;
#pragma unroll
        for (unsigned j = 0; j < 16; ++j) { const unsigned c = xb_ld(&bar[XB_XCNT(j)]); sum += c; cnt += (c > 0u) ? 1u : 0u; mine = (j == x) ? c : mine; }
        if (sum == G) break;
        __builtin_amdgcn_s_sleep(1);
        if ((++sp & 255u) == 0u) { if (xb_ld(&bar[XB_TMO])) break; if (sp > XB_SPIN_CAP) { atomicAdd(&bar[XB_TMO], 1u); break; } }
    }
    nloc = mine > 0u ? mine : 1u; nx = cnt > 0u ? cnt : 1u;
}

__device__ __forceinline__ void xcd_barrier(const XcdBarrier& b) {
    asm volatile("s_waitcnt vmcnt(0)" ::: "memory");
    __syncthreads();
    if (threadIdx.x == 0) {
        unsigned* bar = b.bar;
        __builtin_amdgcn_s_waitcnt(0);
        unsigned nloc = b.st[0], nx = b.st[1];
        if (nloc == 0u) { xcd_barrier_complete(bar, b.x, nloc, nx); b.st[0] = nloc; b.st[1] = nx; }
        const unsigned old = xb_add(&bar[XB_XSUB(b.x)], 1u);
        const unsigned gen = old / nloc;
        if (old + 1u == (gen + 1u) * nloc) {
            __builtin_amdgcn_fence(__ATOMIC_RELEASE, "agent");
            asm volatile("s_waitcnt vmcnt(0)" ::: "memory");
            const unsigned og = xb_add(&bar[XB_TOP], 1u);
            const unsigned tg = og / nx;
            if (og + 1u == (tg + 1u) * nx) xb_add(&bar[XB_TOPGEN], 1u);
            else XB_SPIN(xb_ld(&bar[XB_TOPGEN]) == tg, bar);
            __builtin_amdgcn_fence(__ATOMIC_ACQUIRE, "agent");
            xb_add(&bar[XB_XGEN(b.x)], 1u);
            asm volatile("s_waitcnt vmcnt(0)" ::: "memory");
        } else {
            XB_SPIN(xb_ld(&bar[XB_XGEN(b.x)]) == gen, bar);
            __builtin_amdgcn_fence(__ATOMIC_ACQUIRE, "agent");
            asm volatile("s_waitcnt vmcnt(0)" ::: "memory");
        }
    }
    __syncthreads();
}

constexpr size_t MiB = 1u << 20;
constexpr size_t WS_CTL = 0, CTL_ZERO_BYTES = 1 * MiB;
constexpr int CW_BAR = 4096;
constexpr size_t WS_MODACC = 256 * 1024;
constexpr size_t WS_GATE = 1 * MiB;
constexpr size_t WS_ROPE = 1 * MiB + 64 * 1024;
constexpr size_t WS_WIN = 2 * MiB, WS_WOUT = 10 * MiB;
constexpr size_t WS_H = 16 * MiB;
constexpr size_t WS_Q = 88 * MiB;
constexpr size_t WS_K = 124 * MiB, WS_V = 162 * MiB;
constexpr size_t WS_GA = 200 * MiB, WS_U = 236 * MiB, WS_CBG = 272 * MiB;
constexpr size_t WS_MIX = 308 * MiB, WS_END = 380 * MiB;
static_assert(WS_MODACC + 9 * 3072 * 8 <= CTL_ZERO_BYTES && WS_ROPE + 2 * 64 * 16 * 4 <= WS_WIN && WS_WIN + (size_t)DIN * DM * 2 <= WS_WOUT && WS_WOUT + (size_t)DM * DM * 2 <= WS_H, "ws map 1");
static_assert(WS_H + (size_t)MROWS * DM * 2 <= WS_Q && WS_Q + (size_t)MROWS * DH * 2 <= WS_K && WS_K + (size_t)KVROWS * DH * 2 <= WS_V && WS_V + (size_t)KVROWS * DH * 2 <= WS_GA, "ws map 2");
static_assert(WS_GA + (size_t)MROWS * DH * 2 <= WS_U && WS_U + (size_t)MROWS * DH * 2 <= WS_CBG && WS_CBG + (size_t)MROWS * DH * 2 <= WS_MIX && WS_MIX + (size_t)MROWS * DM * 2 <= WS_END, "ws map 3");
constexpr size_t OUT_Y = 0, OUT_NCK = (size_t)MROWS * DM, OUT_NCV = OUT_NCK + (size_t)MC * DH, OUT_END = OUT_NCV + (size_t)MC * DH;

constexpr int NWAVES = 8;
constexpr int RING_OFF = 0, RING_BYTES = 131072;
constexpr int LDSCTL_OFF = RING_BYTES, MISC_OFF = LDSCTL_OFF + 320;
constexpr int LDS_BYTES = 147456;
static_assert(att::ATT_LDS_BYTES <= RING_BYTES && MISC_OFF + 128 <= LDS_BYTES, "LDS map");
constexpr int N_PHASES = 5;
#ifndef MK_ONE_LAUNCH
#define MK_ONE_LAUNCH 1
#endif

__device__ __forceinline__ float wave_sum(float v) {
#pragma unroll
    for (int o = 1; o < 64; o <<= 1) v += __shfl_xor(v, o);
    return v;
}
template <class Dest>
__device__ __forceinline__ void p0_transpose_item(const float* W, int K, int N, bf16* WT, LAS float* scr, int item, int lane, Dest dest) {
    const int nblk = N / 32, kb = item / nblk, nb = item % nblk, k0 = 64 * kb, n0 = 32 * nb;
#pragma unroll 8
    for (int i = 0; i < 32; ++i) { const int kk = 2 * i + (lane >> 5); scr[kk * 33 + (lane & 31)] = W[(size_t)(k0 + kk) * N + n0 + (lane & 31)]; }
    LDS_WAIT(); asm volatile("" ::: "memory");
    const int c = lane & 7;
#pragma unroll
    for (int j = 0; j < 4; ++j) { const int n = (lane >> 3) + 8 * j; const LAS float* s = scr + (8 * c) * 33 + n;
        v4u o; o.x = pk2(s[0 * 33], s[1 * 33]); o.y = pk2(s[2 * 33], s[3 * 33]); o.z = pk2(s[4 * 33], s[5 * 33]); o.w = pk2(s[6 * 33], s[7 * 33]);
        *(GAS v4u*)(WT + (size_t)dest(n0 + n) * K + k0 + 8 * c) = o; }
    LDS_WAIT(); asm volatile("" ::: "memory");
}
struct DestWin { __device__ __forceinline__ int operator()(int s) const { return pg8::win_dest_row(s); } };
struct DestId  { __device__ __forceinline__ int operator()(int s) const { return s; } };
__device__ __forceinline__ float fix2f(unsigned long long v) { return (float)((double)(long long)v * (1.0 / 4294967296.0)); }

struct Args { const float* in[20]; float* out; unsigned char* ws; int ph_lo, ph_hi; };

__global__ void __launch_bounds__(NWAVES * 64, 2) hymba_fwd(Args args) {
    extern __shared__ __attribute__((aligned(16))) unsigned char lds_raw[];
    LAS unsigned char* lds = (LAS unsigned char*)lds_raw;
    volatile LAS unsigned* MISC = (volatile LAS unsigned*)(lds + MISC_OFF);
    const int tid = threadIdx.x, lane = tid & 63, wave = __builtin_amdgcn_readfirstlane(tid >> 6);
    const int G = gridDim.x; const int vcu = (G % 8 == 0) ? ((int)blockIdx.x % 8) * (G / 8) + (int)blockIdx.x / 8 : (int)blockIdx.x;
    unsigned char* ws = args.ws;
    gu32* ctl = (gu32*)(ws + WS_CTL);
    const float* x_prompt = args.in[0]; const float* x_sample = args.in[1]; const float* cache_k = args.in[2]; const float* cache_v = args.in[3];
    const float* cvec = args.in[4]; const float* c_ctx = args.in[5]; const float* norm_w = args.in[6]; const float* w_ada = args.in[7]; const float* b_ada = args.in[8];
    const float* w_in = args.in[9]; const float* q_norm_w = args.in[10]; const float* k_norm_w = args.in[11];
    const float* lq1 = args.in[12]; const float* lk1 = args.in[13]; const float* lq2 = args.in[14]; const float* lk2 = args.in[15];
    const float* subln_w = args.in[16]; const float* conv_w = args.in[17]; const float* conv_b = args.in[18]; const float* w_out = args.in[19];
    float* out = args.out;
    unsigned long long* modacc = (unsigned long long*)(ws + WS_MODACC);
    float* gate = (float*)(ws + WS_GATE); float* ropec = (float*)(ws + WS_ROPE); float* ropes = ropec + 64 * 16;
    bf16* Win_t = (bf16*)(ws + WS_WIN); bf16* Wout_t = (bf16*)(ws + WS_WOUT); bf16* Hb = (bf16*)(ws + WS_H);
    bf16* Qb = (bf16*)(ws + WS_Q); bf16* Kb = (bf16*)(ws + WS_K); bf16* Vb = (bf16*)(ws + WS_V);
    bf16* GAb = (bf16*)(ws + WS_GA); bf16* Ub = (bf16*)(ws + WS_U); bf16* CBGb = (bf16*)(ws + WS_CBG); bf16* MIXb = (bf16*)(ws + WS_MIX);

    for (int u = tid; u < (LDS_BYTES - LDSCTL_OFF) / 4; u += NWAVES * 64) ((LAS unsigned*)(lds + LDSCTL_OFF))[u] = 0u;
    __syncthreads();
    const int lo = args.ph_lo, hi = args.ph_hi;
    const bool use_bar = (hi - lo) > 1;
    XcdBarrier bar; bar.bar = (unsigned*)(ctl + CW_BAR); bar.x = 0; bar.st = nullptr;
    if (use_bar) bar = xcd_barrier_post((unsigned*)(ctl + CW_BAR), MISC + 8);
#ifndef PHMASK
#define PHMASK 31
#endif
#define IN(k) (((PHMASK >> (k)) & 1) && lo <= (k) && (k) < hi)
#define SEAM(k) do { if (IN(k) && IN((k) + 1)) xcd_barrier(bar); } while (0)
    const int gw = vcu * NWAVES + wave, NGW = G * NWAVES;

    if (IN(0)) {
        LAS float* scr = (LAS float*)(lds + RING_OFF + wave * 16384);
        constexpr int I_IN = (DM / 64) * (DIN / 32), I_OUT = (DM / 64) * (DM / 32), I_MOD = 48 * 16;
        for (int it = gw; it < I_MOD + I_IN + I_OUT; it += NGW) {
            int r = it;
            if (r < I_MOD) {
                const int cc = r % 48, kc = r / 48, col = cc * 64 + lane, k0 = kc * 64;
                float sv[9], acc[9];
#pragma unroll
                for (int b = 0; b < 9; ++b) { const float cv = (b == 0) ? c_ctx[k0 + lane] : cvec[(b - 1) * DM + k0 + lane]; sv[b] = cv / (1.0f + expf(-cv)); acc[b] = 0.f; }
#pragma unroll 8
                for (int kk = 0; kk < 64; ++kk) { const float w = w_ada[(size_t)(k0 + kk) * (3 * DM) + col];
#pragma unroll
                    for (int b = 0; b < 9; ++b) acc[b] = fmaf(__uint_as_float(__builtin_amdgcn_readlane(__float_as_uint(sv[b]), kk)), w, acc[b]); }
#pragma unroll
                for (int b = 0; b < 9; ++b) { const long long q = __float2ll_rn(acc[b] * 4294967296.0f);
                    __hip_atomic_fetch_add(modacc + b * (3 * DM) + col, (unsigned long long)q, __ATOMIC_RELAXED, __HIP_MEMORY_SCOPE_AGENT); }
                continue; }
            r -= I_MOD;
            if (r < I_IN) { p0_transpose_item(w_in, DM, DIN, Win_t, scr, r, lane, DestWin()); continue; }
            r -= I_IN;
            p0_transpose_item(w_out, DM, DM, Wout_t, scr, r, lane, DestId());
        }
        for (int i = gw * 64 + lane; i < 2 * NLATB * PAST * DH / 8; i += NGW * 64) {
            const int half = NLATB * PAST * DH / 8; const bool isv = i >= half; const int e = (isv ? i - half : i) * 8;
            const int b = e / (PAST * DH), j = (e / DH) % PAST, c = e % DH;
            const float* src = (isv ? cache_v : cache_k) + e; const f32x4 a = *(const f32x4*)src, bb = *(const f32x4*)(src + 4);
            v4u o; o.x = pk2(a[0], a[1]); o.y = pk2(a[2], a[3]); o.z = pk2(bb[0], bb[1]); o.w = pk2(bb[2], bb[3]);
            *(v4u*)((isv ? Vb : Kb) + (size_t)(MC + b * KVL + SEQL + j) * DH + c) = o;
        }
        if (blockIdx.x == 0) { for (int i = tid; i < 64 * 16; i += NWAVES * 64) { const int p = i >> 4, f = i & 15;
            const float inv = 1.0f / powf(10000.0f, (float)f / 16.0f); const float ang = (float)p * inv; ropec[i] = cosf(ang); ropes[i] = sinf(ang); } }
    }
    SEAM(0);
    if (IN(1)) {
        LAS float* gs = (LAS float*)(lds + RING_OFF);
        for (int i = blockIdx.x * (NWAVES * 64) + tid; i < 9 * DM; i += G * NWAVES * 64) { const int b = i >> 10, j = i & 1023;
            gate[i] = fix2f(__hip_atomic_load(modacc + b * (3 * DM) + 2 * DM + j, RLX_AGENT)) + b_ada[2 * DM + j]; }
        const int rows_per = (MROWS + G - 1) / G;
        const int r0 = (int)blockIdx.x * rows_per, r1 = (r0 + rows_per < MROWS) ? r0 + rows_per : MROWS;
        if (r0 < r1) {
            const int mb_lo = r0 < MC ? 0 : 1 + ((r0 - MC) >> 12), mb_hi = (r1 - 1) < MC ? 0 : 1 + ((r1 - 1 - MC) >> 12);
            for (int i = tid; i < 2 * DM; i += NWAVES * 64) { const int slot = i >> 10, k = i & 1023, mb = slot ? mb_hi : mb_lo;
                const float shift = fix2f(__hip_atomic_load(modacc + mb * (3 * DM) + k, RLX_AGENT)) + b_ada[k];
                const float scale = fix2f(__hip_atomic_load(modacc + mb * (3 * DM) + DM + k, RLX_AGENT)) + b_ada[DM + k];
                gs[slot * 2048 + k] = norm_w[k] * (1.0f + scale); gs[slot * 2048 + 1024 + k] = shift; }
            __syncthreads();
            for (int row = r0 + wave; row < r1; row += NWAVES) {
                const int mb = row < MC ? 0 : 1 + ((row - MC) >> 12); const LAS float* gp = gs + (mb != mb_lo ? 2048 : 0);
                const float* xrow = row < MC ? x_prompt + (size_t)row * DM : x_sample + (size_t)(row - MC) * DM;
                const GAS f32x4* xr = (const GAS f32x4*)xrow + lane;
                f32x4 v[4]; float s2 = 0.f;
#pragma unroll
                for (int j = 0; j < 4; ++j) { v[j] = xr[64 * j]; s2 += (v[j].x * v[j].x + v[j].y * v[j].y) + (v[j].z * v[j].z + v[j].w * v[j].w); }
                const float rstd = 1.0f / sqrtf(wave_sum(s2) * (1.0f / DM) + RMS_EPS);
                GAS unsigned long long* o8 = (GAS unsigned long long*)(Hb + (size_t)row * DM) + lane;
#pragma unroll
                for (int j = 0; j < 4; ++j) { const f32x4 g4 = *(const LAS f32x4*)(gp + 256 * j + 4 * lane), s4 = *(const LAS f32x4*)(gp + 1024 + 256 * j + 4 * lane);
                    const f32x4 h4 = (v[j] * rstd) * g4 + s4;
                    o8[64 * j] = (unsigned long long)pk2(h4.x, h4.y) | ((unsigned long long)pk2(h4.z, h4.w) << 32); }
            }
        }
        __syncthreads();
    }
    SEAM(1);
    if (IN(2)) {
        pg8::Gemm g{Hb, Win_t, MROWS, DIN, DM}; pg8::StaticOrder S; S.init(MROWS, DIN, G, (int)blockIdx.x);
        pg8::EpiProj E{Qb, Kb, Vb, GAb, Ub, CBGb, out + OUT_NCK, out + OUT_NCV, q_norm_w, k_norm_w, ropec, ropes};
        pg8::gemm_phase<pg8::EpiProj, pg8::StaticOrder, true, true>(lds + RING_OFF, g, S, E);
    }
    SEAM(2);
    if (IN(3)) {
        {
            float w0[8], w1[8], w2[8], bb[8];
#pragma unroll
            for (int e = 0; e < 8; ++e) { const int c = 8 * lane + e; w0[e] = conv_w[c]; w1[e] = conv_w[DH + c]; w2[e] = conv_w[2 * DH + c]; bb[e] = conv_b[c]; }
            const int rows_per = (MROWS + NGW - 1) / NGW;
            const int r0 = gw * rows_per, r1 = (r0 + rows_per < MROWS) ? r0 + rows_per : MROWS;
#pragma unroll 2
            for (int row = r0; row < r1; ++row) {
                const int t = row < MC ? (row & (SEQC - 1)) : ((row - MC) & (SEQL - 1)), last = row < MC ? SEQC - 1 : SEQL - 1;
                const v4u z = {0u, 0u, 0u, 0u};
                const v4u uc = *(const v4u*)(Ub + (size_t)row * DH + 8 * lane);
                const v4u up = t > 0 ? *(const v4u*)(Ub + (size_t)(row - 1) * DH + 8 * lane) : z;
                const v4u un = t < last ? *(const v4u*)(Ub + (size_t)(row + 1) * DH + 8 * lane) : z;
                const v4u cg = *(const v4u*)(CBGb + (size_t)row * DH + 8 * lane);
                float r[8];
#pragma unroll
                for (int e = 0; e < 4; ++e) {
                    const unsigned a = up[e], b = uc[e], c = un[e], d = cg[e];
                    const float lo_ = fmaf(w0[2 * e], __uint_as_float(a << 16), fmaf(w1[2 * e], __uint_as_float(b << 16), fmaf(w2[2 * e], __uint_as_float(c << 16), bb[2 * e])));
                    const float hi_ = fmaf(w0[2 * e + 1], __uint_as_float(a & 0xffff0000u), fmaf(w1[2 * e + 1], __uint_as_float(b & 0xffff0000u), fmaf(w2[2 * e + 1], __uint_as_float(c & 0xffff0000u), bb[2 * e + 1])));
                    r[2 * e] = lo_ * __uint_as_float(d << 16); r[2 * e + 1] = hi_ * __uint_as_float(d & 0xffff0000u);
                }
                v4u o; o.x = pk2(r[0], r[1]); o.y = pk2(r[2], r[3]); o.z = pk2(r[4], r[5]); o.w = pk2(r[6], r[7]);
                *(v4u*)(MIXb + (size_t)row * DM + DH + 8 * lane) = o;
            }
        }
        float lam;
        { const float a = wave_sum(lq1[lane] * lk1[lane]), b = wave_sum(lq2[lane] * lk2[lane]); lam = expf(a) - expf(b) + LAM_INIT; }
        const int per_x = (G % 8 == 0) ? G / 8 : 0;
        const int n_lat = NLATB * 4 * (SEQL / 128), n_ctx = NCTXB * 4 * 2;
        for (int i = 0;; ++i) {
            int un;
            if (per_x >= 32) { const int xcd = vcu / per_x, ci = vcu % per_x;
                if (i < 4) { if (ci >= 32) continue; un = (8 * i + xcd) * 32 + ci; }
                else { un = n_lat + (i - 4) * G + vcu; if (un >= n_lat + n_ctx) break; } }
            else { un = i * G + (int)blockIdx.x; if (un >= n_lat + n_ctx) break; }
            size_t qrow, krow0; int seq, h;
            if (un < n_lat) { const int bh = un >> 5, qb = un & 31, b = bh >> 2; h = bh & 3; qrow = (size_t)MC + (size_t)b * SEQL + (size_t)qb * 128; krow0 = (size_t)MC + (size_t)b * KVL; seq = KVL; }
            else { const int uc = un - n_lat, b = uc >> 3, qb = uc & 1; h = (uc >> 1) & 3; qrow = (size_t)b * SEQC + (size_t)qb * 128; krow0 = (size_t)b * SEQC; seq = SEQC; }
            att::attn_unit(Qb + qrow * DH + h * 128, Kb + krow0 * DH + h * 128, Vb + krow0 * DH + h * 128, GAb + qrow * DH + h * 128, MIXb + qrow * DM + h * 128, seq, lam, subln_w, (char*)lds_raw + RING_OFF);
        }
        __syncthreads();
    }
    SEAM(3);
    if (IN(4)) {
        pg8::Gemm g{MIXb, Wout_t, MROWS, DM, DM}; pg8::StaticOrder S; S.init(MROWS, DM, G, (int)blockIdx.x);
        pg8::EpiOut E{x_prompt, x_sample, gate, out + OUT_Y};
        pg8::gemm_phase<pg8::EpiOut, pg8::StaticOrder, true, true>(lds + RING_OFF, g, S, E);
    }
#undef IN
#undef SEAM
}

extern "C" void kernel_launch(void* const* d_in, const int* in_sizes, int n_in, void* d_out, int out_size, void* d_ws, size_t ws_size, hipStream_t stream) {
    static int grid = 0;
    if (grid == 0) {
        if (n_in != 20 || in_sizes[0] != MC * DM || in_sizes[1] != ML * DM || (size_t)out_size != OUT_END || ws_size < WS_END) {
            fprintf(stderr, "kernel_launch: shape mismatch: n_in %d in0 %d in1 %d out %d ws %zu (need >= %zu)\n", n_in, n_in > 0 ? in_sizes[0] : -1, n_in > 1 ? in_sizes[1] : -1, out_size, ws_size, (size_t)WS_END);
            grid = -1; return; }
        int dev = 0, cus = 0, per_cu = 0;
        if (hipGetDevice(&dev) != hipSuccess || hipDeviceGetAttribute(&cus, hipDeviceAttributeMultiprocessorCount, dev) != hipSuccess) { fprintf(stderr, "kernel_launch: device query failed\n"); grid = -1; return; }
        if (hipFuncSetAttribute((const void*)hymba_fwd, hipFuncAttributeMaxDynamicSharedMemorySize, LDS_BYTES) != hipSuccess) { fprintf(stderr, "kernel_launch: hipFuncSetAttribute failed\n"); grid = -1; return; }
        if (hipOccupancyMaxActiveBlocksPerMultiprocessor(&per_cu, (const void*)hymba_fwd, NWAVES * 64, LDS_BYTES) != hipSuccess || per_cu < 1)
            fprintf(stderr, "kernel_launch: note: occupancy query reports %d workgroups per CU\n", per_cu);
        (void)hipGetLastError();
        grid = cus;
        if (grid != 256) fprintf(stderr, "kernel_launch: note: %d CUs (tuned for 256)\n", grid);
    }
    if (grid < 0) return;
    if (hipMemsetAsync((char*)d_ws + WS_CTL, 0, CTL_ZERO_BYTES, stream) != hipSuccess) { fprintf(stderr, "kernel_launch: memset failed\n"); return; }
    Args a{};
    for (int i = 0; i < 20; ++i) a.in[i] = (const float*)d_in[i];
    a.out = (float*)d_out; a.ws = (unsigned char*)d_ws;
#if MK_ONE_LAUNCH
    a.ph_lo = 0; a.ph_hi = N_PHASES;
    hipLaunchKernelGGL(hymba_fwd, dim3(grid), dim3(NWAVES * 64), LDS_BYTES, stream, a);
#else
    for (int p = 0; p < N_PHASES; ++p) { a.ph_lo = p; a.ph_hi = p + 1; hipLaunchKernelGGL(hymba_fwd, dim3(grid), dim3(NWAVES * 64), LDS_BYTES, stream, a); }
#endif
    const hipError_t le = hipPeekAtLastError();
    if (le != hipSuccess) fprintf(stderr, "kernel_launch: launch failed: %s\n", hipGetErrorName(le));
}
```

```cpp
#include <hip/hip_runtime.h>
#include <hip/hip_bf16.h>
#include <cstdio>
#include <cstdint>
#include <cmath>
namespace pg8 {
#define PG8_LAS __attribute__((address_space(3)))
typedef unsigned short bf16_t;
typedef short bf16x8 __attribute__((ext_vector_type(8)));
typedef float f32x4 __attribute__((ext_vector_type(4)));
typedef unsigned u32x4 __attribute__((ext_vector_type(4)));
constexpr int BM = 256, BK = 64, HALF = 128, HTB = HALF * BK * 2  , STAGE_BYTES = 8 * HTB, NXCD = 8, WGM = 8;

__host__ __device__ __forceinline__ int lds_byte(int r, int c) { const int st = (r >> 4) * 2 + (c >> 5), rr = r & 15, cc = c & 31, ob = rr * 64 + cc * 2; return st * 1024 + (ob ^ (((ob >> 9) & 1) << 5)); }
__host__ __device__ __forceinline__ void stage_rc(int b, int& R, int& C) { const int st = b / 1024, sb = b % 1024, swz = sb ^ (((sb >> 9) & 1) << 5); R = (st >> 1) * 16 + swz / 64; C = (st & 1) * 32 + (swz % 64) / 2; }
__host__ __device__ __forceinline__ int perm32(int rho) { const int n = rho >> 4, i = rho & 15; return 8 * (i >> 2) + 4 * n + (i & 3); }

struct Unit { int pm, pn; };
struct Gemm { const bf16_t* A; const bf16_t* Bt; int M, N, K; };

struct StaticOrder {
    int nM, nN, nwg, G, c;
    __host__ __device__ void init(int M, int N, int G_, int c_) { nM = M / BM; nN = N / BM; nwg = nM * nN; G = G_; c = c_; }
    __host__ __device__ bool next(int i, Unit& u) const {
        const long L = (long)i * G + c; if (L >= nwg) return false;
        int wgid = (int)L; { const int q = nwg / NXCD, r = nwg % NXCD, xcd = wgid % NXCD, off = wgid / NXCD; wgid = (xcd < r ? xcd * (q + 1) : r * (q + 1) + (xcd - r) * q) + off; }
        const int nig = WGM * nN, gid = wgid / nig, fm = gid * WGM, gsz = (nM - fm) < WGM ? (nM - fm) : WGM;
        u.pm = fm + ((wgid % nig) % gsz); u.pn = (wgid % nig) / gsz; return true;
    }
    __device__ __forceinline__ void a_ready(const Unit&) const {}
    __device__ __forceinline__ void done(const Unit&) const {}
};
template <class Epi, class Sched, bool ALIGN_EPI = false, bool SP2 = false>
__device__ __forceinline__ void gemm_phase(PG8_LAS unsigned char* lds, const Gemm g, const Sched& S, const Epi& E) {
    const int tid = threadIdx.x, wid = __builtin_amdgcn_readfirstlane(tid >> 6), lane = tid & 63, wr = wid >> 2, wc = wid & 3, fr = lane & 15, fq = lane >> 4;
    const int K = g.K, nt = K / BK;
    unsigned voffA[2], voffB[2];
#pragma unroll
    for (int i = 0; i < 2; ++i) { int R, C; stage_rc(tid * 16 + i * 8192, R, C); const int Rb = Epi::PERM ? ((R & ~31) + perm32(R & 31)) : R;
        voffA[i] = (unsigned)(R * K + C) * 2u; voffB[i] = (unsigned)(Rb * K + C) * 2u; }
    const size_t kstep = (size_t)(BK * 2);
    const size_t hstep = (size_t)HALF * K * 2;
    const size_t tstep = 2 * hstep;
    const unsigned ldsw = (unsigned)wid * 1024u;
    const int aoff = lds_byte(wr * 64 + fr, fq * 8), boff = lds_byte(wc * 32 + fr, fq * 8);
#define PG8_SA(b, h) (((b) * 2 + (h)) * HTB)
#define PG8_SB(b, h) ((4 + (b) * 2 + (h)) * HTB)
#define PG8_STAGE(bufoff, gbase, voff) do { _Pragma("unroll") for (int _i = 0; _i < 2; ++_i) \
        __builtin_amdgcn_global_load_lds((const unsigned*)((const char*)(gbase) + (voff)[_i]), (PG8_LAS unsigned*)(lds + (bufoff) + ldsw + _i * 8192), 16, 0, 0); } while (0)
#define PG8_LDA(dst, b, h) do { _Pragma("unroll") for (int m = 0; m < 4; ++m) _Pragma("unroll") for (int k = 0; k < 2; ++k) dst[m][k] = *(const PG8_LAS bf16x8*)(lds + PG8_SA(b, h) + aoff + m * 2048 + k * 1024); } while (0)
#define PG8_LDB(dst, b, h) do { _Pragma("unroll") for (int n = 0; n < 2; ++n) _Pragma("unroll") for (int k = 0; k < 2; ++k) dst[n][k] = *(const PG8_LAS bf16x8*)(lds + PG8_SB(b, h) + boff + n * 2048 + k * 1024); } while (0)
#define PG8_MMA(ai, bj, At, Bt) do { __builtin_amdgcn_s_setprio(1); _Pragma("unroll") for (int m = 0; m < 4; ++m) _Pragma("unroll") for (int n = 0; n < 2; ++n) _Pragma("unroll") for (int k = 0; k < 2; ++k) \
        acc[ai][bj][m][n] = __builtin_amdgcn_mfma_f32_16x16x32_bf16(Bt[n][k], At[m][k], acc[ai][bj][m][n], 0, 0, 0); __builtin_amdgcn_s_setprio(0); } while (0)
#define PG8_WAIT_V(n) asm volatile("s_waitcnt vmcnt(" #n ")" ::: "memory")
#define PG8_WAIT_L(n) asm volatile("s_waitcnt lgkmcnt(" #n ")" ::: "memory")
#define PG8_BAR __builtin_amdgcn_s_barrier()
#define PG8_SCHED __builtin_amdgcn_sched_barrier(0)
    Unit cur, nxt; int ui = 0;
    if (!S.next(0, cur)) return;
    f32x4 acc[2][2][4][2];
#pragma unroll
    for (int a = 0; a < 2; ++a)
#pragma unroll
        for (int b = 0; b < 2; ++b)
#pragma unroll
            for (int m = 0; m < 4; ++m)
#pragma unroll
                for (int n = 0; n < 2; ++n) acc[a][b][m][n] = (f32x4){0.f, 0.f, 0.f, 0.f};
    bf16x8 At[4][2], B0[2][2], B1[2][2];
    const char* cA = (const char*)g.A + (size_t)cur.pm * tstep; const char* cB = (const char*)g.Bt + (size_t)cur.pn * tstep;
    S.a_ready(cur);
    if constexpr (SP2) {
        PG8_STAGE(PG8_SB(0, 0), cB, voffB); PG8_STAGE(PG8_SB(0, 1), cB + hstep, voffB); PG8_STAGE(PG8_SA(0, 0), cA, voffA); PG8_STAGE(PG8_SA(0, 1), cA + hstep, voffA);
        if (wr == 1) PG8_BAR;
        PG8_WAIT_V(2); PG8_BAR;
        PG8_STAGE(PG8_SB(1, 0), cB + kstep, voffB); PG8_STAGE(PG8_SA(1, 0), cA + kstep, voffA); PG8_STAGE(PG8_SB(1, 1), cB + hstep + kstep, voffB);
        PG8_WAIT_V(6); PG8_BAR;
    } else {
        PG8_STAGE(PG8_SB(0, 0), cB, voffB); PG8_STAGE(PG8_SA(0, 0), cA, voffA); PG8_STAGE(PG8_SB(0, 1), cB + hstep, voffB); PG8_STAGE(PG8_SA(0, 1), cA + hstep, voffA);
        if (wr == 1) PG8_BAR;
        PG8_WAIT_V(4); PG8_BAR;
        PG8_STAGE(PG8_SB(1, 0), cB + kstep, voffB); PG8_STAGE(PG8_SA(1, 0), cA + kstep, voffA); PG8_STAGE(PG8_SB(1, 1), cB + hstep + kstep, voffB);
        PG8_WAIT_V(6); PG8_BAR;
    }
    for (;;) {
        const bool has_next = S.next(ui + 1, nxt);
        const char* nA = has_next ? (const char*)g.A + (size_t)nxt.pm * tstep : cA; const char* nB = has_next ? (const char*)g.Bt + (size_t)nxt.pn * tstep : cB;
        for (int t = 0; t < nt; t += 2) {
            const bool last = (t == nt - 2);
            const char* a1 = cA + (size_t)(t + 1) * kstep;
            const char* a2 = last ? nA : cA + (size_t)(t + 2) * kstep; const char* b2 = last ? nB : cB + (size_t)(t + 2) * kstep;
            const char* a3 = a2 + kstep; const char* b3 = b2 + kstep;
            if (last && has_next) S.a_ready(nxt);
            if constexpr (SP2) {
            PG8_LDB(B0, 0, 0); PG8_LDB(B1, 0, 1); PG8_SCHED; PG8_LDA(At, 0, 0); PG8_STAGE(PG8_SA(1, 1), a1 + hstep, voffA);
            PG8_WAIT_V(8); PG8_WAIT_L(0); PG8_BAR; PG8_MMA(0, 0, At, B0); PG8_MMA(0, 1, At, B1); PG8_BAR; PG8_SCHED;
            PG8_LDA(At, 0, 1); PG8_STAGE(PG8_SB(0, 0), b2, voffB); PG8_STAGE(PG8_SB(0, 1), b2 + hstep, voffB); PG8_STAGE(PG8_SA(0, 0), a2, voffA);
            PG8_WAIT_V(8); PG8_WAIT_L(0); PG8_BAR; PG8_MMA(1, 0, At, B0); PG8_MMA(1, 1, At, B1); PG8_BAR; PG8_SCHED;
            PG8_LDB(B0, 1, 0); PG8_LDB(B1, 1, 1); PG8_SCHED; PG8_LDA(At, 1, 0); PG8_STAGE(PG8_SA(0, 1), a2 + hstep, voffA);
            PG8_WAIT_V(8); PG8_WAIT_L(0); PG8_BAR; PG8_MMA(0, 0, At, B0); PG8_MMA(0, 1, At, B1); PG8_BAR; PG8_SCHED;
            PG8_LDA(At, 1, 1); PG8_STAGE(PG8_SB(1, 0), b3, voffB); PG8_STAGE(PG8_SB(1, 1), b3 + hstep, voffB); PG8_STAGE(PG8_SA(1, 0), a3, voffA);
            PG8_WAIT_V(8); PG8_WAIT_L(0); PG8_BAR; PG8_MMA(1, 0, At, B0); PG8_MMA(1, 1, At, B1); PG8_BAR; PG8_SCHED;
            } else {
            PG8_LDB(B0, 0, 0); PG8_SCHED; PG8_LDA(At, 0, 0); PG8_STAGE(PG8_SA(1, 1), a1 + hstep, voffA);
            PG8_WAIT_L(8); PG8_BAR; PG8_WAIT_L(0); PG8_MMA(0, 0, At, B0); PG8_BAR; PG8_SCHED;
            PG8_LDB(B1, 0, 1); PG8_STAGE(PG8_SB(0, 0), b2, voffB);
            PG8_BAR; PG8_WAIT_L(0); PG8_MMA(0, 1, At, B1); PG8_BAR;
            PG8_LDA(At, 0, 1); PG8_STAGE(PG8_SA(0, 0), a2, voffA);
            PG8_BAR; PG8_WAIT_L(0); PG8_MMA(1, 0, At, B0); PG8_BAR; PG8_SCHED;
            PG8_STAGE(PG8_SB(0, 1), b2 + hstep, voffB);
            PG8_WAIT_V(6); PG8_BAR; PG8_MMA(1, 1, At, B1); PG8_BAR;
            PG8_LDB(B0, 1, 0); PG8_SCHED; PG8_LDA(At, 1, 0); PG8_STAGE(PG8_SA(0, 1), a2 + hstep, voffA);
            PG8_WAIT_L(8); PG8_BAR; PG8_WAIT_L(0); PG8_MMA(0, 0, At, B0); PG8_BAR; PG8_SCHED;
            PG8_LDB(B1, 1, 1); PG8_STAGE(PG8_SB(1, 0), b3, voffB);
            PG8_BAR; PG8_WAIT_L(0); PG8_MMA(0, 1, At, B1); PG8_BAR;
            PG8_LDA(At, 1, 1); PG8_STAGE(PG8_SA(1, 0), a3, voffA);
            PG8_BAR; PG8_WAIT_L(0); PG8_MMA(1, 0, At, B0); PG8_BAR; PG8_SCHED;
            PG8_STAGE(PG8_SB(1, 1), b3 + hstep, voffB);
            PG8_WAIT_V(6); PG8_BAR; PG8_MMA(1, 1, At, B1); PG8_BAR;
            }
        }
        if constexpr (ALIGN_EPI) { if (wr == 0) PG8_BAR; }
        if constexpr (!Epi::AFTER_DRAIN) { E(acc, cur, wr, wc, fr, fq); S.done(cur); }
        if (!has_next) break;
#pragma unroll
        for (int a = 0; a < 2; ++a)
#pragma unroll
            for (int b = 0; b < 2; ++b)
#pragma unroll
                for (int m = 0; m < 4; ++m)
#pragma unroll
                    for (int n = 0; n < 2; ++n) acc[a][b][m][n] = (f32x4){0.f, 0.f, 0.f, 0.f};
        cur = nxt; cA = nA; cB = nB; ++ui;
        if constexpr (ALIGN_EPI) { if (wr == 1) PG8_BAR; }
    }
    PG8_WAIT_V(0);
    if constexpr (!ALIGN_EPI) { if (wr == 0) PG8_BAR; }
    PG8_BAR;
    if constexpr (Epi::AFTER_DRAIN) { E.fused(acc, cur, wr, wc, fr, fq, lds, wid, lane); S.done(cur); }
#undef PG8_SA
#undef PG8_SB
#undef PG8_STAGE
#undef PG8_LDA
#undef PG8_LDB
#undef PG8_MMA
#undef PG8_WAIT_V
#undef PG8_WAIT_L
#undef PG8_BAR
#undef PG8_SCHED
}
}

constexpr int DM = 1024, DIN = 4096, NCTXB = 16, SEQC = 256, NLATB = 8, SEQL = 4096, PAST = 256;
constexpr int MC = NCTXB * SEQC;
constexpr int ML = NLATB * SEQL;
constexpr int MROWS = MC + ML;
constexpr int KVL = SEQL + PAST;
constexpr int KVROWS = MC + NLATB * KVL;
constexpr int DH = 512;
constexpr float RMS_EPS = 1e-6f;
constexpr float LAM_INIT = 0.2f;
constexpr float QC2 = 0.125f * 1.4426950408889634f;
__host__ __device__ __forceinline__ int krow_of(int row) { return row < MC ? row : MC + ((row - MC) >> 12) * KVL + ((row - MC) & (SEQL - 1)); }

namespace pg8 {
typedef unsigned u32x2 __attribute__((ext_vector_type(2)));
__device__ __forceinline__ unsigned cvt_pk_bf16(float lo, float hi) { unsigned r; asm volatile("v_cvt_pk_bf16_f32 %0, %1, %2" : "=v"(r) : "v"(lo), "v"(hi)); return r; }
__device__ __forceinline__ float silu_f(float v) { return v * __builtin_amdgcn_rcpf(1.0f + __builtin_amdgcn_exp2f(-1.4426950408889634f * v)); }
__device__ __forceinline__ f32x4 silu4(f32x4 v) { return (f32x4){silu_f(v[0]), silu_f(v[1]), silu_f(v[2]), silu_f(v[3])}; }
__device__ __forceinline__ u32x4 pack8(f32x4 a, f32x4 b) { u32x4 w; w.x = cvt_pk_bf16(a[0], a[1]); w.y = cvt_pk_bf16(a[2], a[3]); w.z = cvt_pk_bf16(b[0], b[1]); w.w = cvt_pk_bf16(b[2], b[3]); return w; }

struct EpiProj {
    static constexpr bool PERM = false, AFTER_DRAIN = false;
    bf16_t *Q, *Kb, *Vb, *GA, *U, *CBG; float *nck, *ncv; const float *qnw, *knw, *ropec, *ropes;
    __device__ __forceinline__ void operator()(const f32x4 (&acc)[2][2][4][2], const Unit& u, int wr, int wc, int fr, int fq) const {
        const int pn = u.pn, pm = u.pm; const bool lat = pm >= (MC / 256);
        const int rbase = pm * BM + wr * 64 + fr;
        if (pn < 4) {
            const bool isk = pn >= 2; const int g = 4 * (pn & 1) + wc, dbase = 32 * (fq >> 1) + 8 * (fq & 1);
            const float* nw = isk ? knw : qnw; const float sc = isk ? 1.0f : QC2;
            f32x4 w[2][2];
#pragma unroll
            for (int bj = 0; bj < 2; ++bj)
#pragma unroll
                for (int n = 0; n < 2; ++n) w[bj][n] = *(const f32x4*)(nw + dbase + 16 * bj + 4 * n);
#pragma unroll
            for (int ai = 0; ai < 2; ++ai)
#pragma unroll
                for (int m = 0; m < 4; ++m) {
                    const int row = rbase + ai * HALF + m * 16;
                    f32x4 v[2][2]; float ss = 0.f;
#pragma unroll
                    for (int bj = 0; bj < 2; ++bj)
#pragma unroll
                        for (int n = 0; n < 2; ++n) { v[bj][n] = acc[ai][bj][m][n]; const f32x4 q = v[bj][n] * v[bj][n]; ss += (q[0] + q[1]) + (q[2] + q[3]); }
                    ss += __shfl_xor(ss, 16); ss += __shfl_xor(ss, 32);
                    const float rstd = 1.0f / sqrtf(ss * (1.0f / 64.0f) + RMS_EPS);
#pragma unroll
                    for (int bj = 0; bj < 2; ++bj)
#pragma unroll
                        for (int n = 0; n < 2; ++n) v[bj][n] = (v[bj][n] * rstd) * w[bj][n];
                    if (lat) {
                        const int t = (row - MC) & (SEQL - 1), p = (fq >> 1) ? (t & 63) : (t >> 6);
                        const float* cp = ropec + p * 16 + 8 * (fq & 1); const float* sp = ropes + p * 16 + 8 * (fq & 1);
#pragma unroll
                        for (int n = 0; n < 2; ++n) { const f32x4 c4 = *(const f32x4*)(cp + 4 * n), s4 = *(const f32x4*)(sp + 4 * n), x1 = v[0][n], x2 = v[1][n];
                            v[0][n] = x1 * c4 - x2 * s4; v[1][n] = x2 * c4 + x1 * s4; }
                    }
                    bf16_t* dst = (isk ? Kb + (size_t)krow_of(row) * DH : Q + (size_t)row * DH) + g * 64 + dbase;
#pragma unroll
                    for (int bj = 0; bj < 2; ++bj) *(u32x4*)(dst + 16 * bj) = pack8(v[bj][0] * sc, v[bj][1] * sc);
                    if (isk && !lat) { float* o = nck + (size_t)row * DH + g * 64 + dbase;
#pragma unroll
                        for (int bj = 0; bj < 2; ++bj) { *(f32x4*)(o + 16 * bj) = v[bj][0]; *(f32x4*)(o + 16 * bj + 4) = v[bj][1]; } }
                }
        } else if (pn < 8) {
            const bool isg = pn >= 6; const int cbase = 256 * (pn & 1) + 32 * wc + 8 * fq;
#pragma unroll
            for (int ai = 0; ai < 2; ++ai)
#pragma unroll
                for (int m = 0; m < 4; ++m) {
                    const int row = rbase + ai * HALF + m * 16;
                    bf16_t* dst = (isg ? GA + (size_t)row * DH : Vb + (size_t)krow_of(row) * DH) + cbase;
#pragma unroll
                    for (int bj = 0; bj < 2; ++bj) { f32x4 a = acc[ai][bj][m][0], b = acc[ai][bj][m][1];
                        if (!isg && !lat) { float* o = ncv + (size_t)row * DH + cbase + 128 * bj; *(f32x4*)o = a; *(f32x4*)(o + 4) = b; }
                        if (isg) { a = silu4(a); b = silu4(b); }
                        *(u32x4*)(dst + 128 * bj) = pack8(a, b); }
                }
        } else {
            const int ch0 = 64 * (pn - 8) + 16 * wc + 4 * fq;
#pragma unroll
            for (int ai = 0; ai < 2; ++ai)
#pragma unroll
                for (int m = 0; m < 4; ++m) {
                    const int row = rbase + ai * HALF + m * 16;
                    const f32x4 cb = acc[ai][0][m][0], cc = acc[ai][0][m][1], chh = acc[ai][1][m][0], gc = acc[ai][1][m][1];
                    const f32x4 uu = cc * chh, cg = cb * silu4(gc);
                    u32x2 a, b; a.x = cvt_pk_bf16(uu[0], uu[1]); a.y = cvt_pk_bf16(uu[2], uu[3]); b.x = cvt_pk_bf16(cg[0], cg[1]); b.y = cvt_pk_bf16(cg[2], cg[3]);
                    *(u32x2*)(U + (size_t)row * DH + ch0) = a; *(u32x2*)(CBG + (size_t)row * DH + ch0) = b;
                }
        }
    }
};
__host__ __device__ __forceinline__ int win_dest_row(int s) {
    if (s < 1024) { const int sp = s >> 9, g = (s >> 6) & 7, d = s & 63, t = g >> 2, wc = g & 3;
        const int fqh = d >> 5, bj = (d >> 4) & 1, fql = (d >> 3) & 1, n = (d >> 2) & 1, e = d & 3, fq = 2 * fqh + fql;
        return 256 * (2 * sp + t) + 128 * bj + 32 * wc + 16 * n + 4 * fq + e; }
    if (s < 2048) { const int c = s & 255, pn = s >> 8, bj = c >> 7, wc = (c >> 5) & 3, fq = (c >> 3) & 3, n = (c >> 2) & 1, e = c & 3;
        return 256 * pn + 128 * bj + 32 * wc + 16 * n + 4 * fq + e; }
    { const int role = (s - 2048) >> 9, ch = s & 511, j = ch >> 6, wc = (ch >> 4) & 3, fq = (ch >> 2) & 3, e = ch & 3, bj = role >> 1, n = role & 1;
        return 256 * (8 + j) + 128 * bj + 32 * wc + 16 * n + 4 * fq + e; }
}
struct EpiOut {
    static constexpr bool PERM = false, AFTER_DRAIN = false;
    const float *xp, *xs, *gate; float* out;
    __device__ __forceinline__ void operator()(const f32x4 (&acc)[2][2][4][2], const Unit& u, int wr, int wc, int fr, int fq) const {
        const int pm = u.pm, mb = pm < (MC / 256) ? 0 : 1 + ((pm - MC / 256) >> 4);
        const int col0 = u.pn * BM + wc * 32 + 4 * fq, rbase = pm * BM + wr * 64 + fr;
        f32x4 g4[2][2];
#pragma unroll
        for (int bj = 0; bj < 2; ++bj)
#pragma unroll
            for (int n = 0; n < 2; ++n) g4[bj][n] = *(const f32x4*)(gate + mb * DM + col0 + bj * HALF + n * 16);
#pragma unroll
        for (int ai = 0; ai < 2; ++ai)
#pragma unroll
            for (int m = 0; m < 4; ++m) {
                const int row = rbase + ai * HALF + m * 16;
                const float* xr = (row < MC ? xp + (size_t)row * DM : xs + (size_t)(row - MC) * DM) + col0; float* orow = out + (size_t)row * DM + col0;
#pragma unroll
                for (int bj = 0; bj < 2; ++bj)
#pragma unroll
                    for (int n = 0; n < 2; ++n) { const f32x4 x4 = *(const f32x4*)(xr + bj * HALF + n * 16); *(f32x4*)(orow + bj * HALF + n * 16) = x4 + g4[bj][n] * acc[ai][bj][m][n]; }
            }
    }
};
}

namespace att2 {
typedef unsigned short bf16_t;
using bf16x8 = __attribute__((ext_vector_type(8))) short;
using s16x4  = __attribute__((ext_vector_type(4))) short;
using f32x16 = __attribute__((ext_vector_type(16))) float;
using f32x4  = __attribute__((ext_vector_type(4))) float;
using u32x4  = __attribute__((ext_vector_type(4))) unsigned;
constexpr int NW = 8, KVBLK = 64;
constexpr int NSLOT = 3, SLOTB = 16384;
constexpr int LDS_K = 0, LDS_V = NSLOT * SLOTB, LDS_WS = 2 * NSLOT * SLOTB, ATT_LDS_BYTES = LDS_WS + NW * 64 * 4;
constexpr int OL_PITCH = 132;
static_assert(128 * OL_PITCH * 4 <= LDS_WS, "combine image inside the rings");
__device__ __forceinline__ int crow(int r, int hi) { return (r & 3) + 8 * (r >> 2) + 4 * hi; }
#define SBAR() __builtin_amdgcn_sched_barrier(0)
__device__ __forceinline__ void glds16(const void* gsrc, unsigned lds_dst) { unsigned keep;
  asm volatile("s_mov_b32 %0, m0\n\ts_mov_b32 m0, %2\n\ts_nop 0\n\tglobal_load_lds_dwordx4 %1, off\n\ts_mov_b32 m0, %0" : "=&s"(keep) : "v"(gsrc), "s"(lds_dst) : "memory"); }
typedef float f32x2_t __attribute__((ext_vector_type(2))); typedef __bf16 bf16x2_t __attribute__((ext_vector_type(2)));
__device__ __forceinline__ unsigned cvtpk_s(float lo, float hi) { f32x2_t v = {lo, hi}; bf16x2_t b = __builtin_convertvector(v, bf16x2_t); return __builtin_bit_cast(unsigned, b); }
#define WAIT_BAR(N) asm volatile("s_waitcnt vmcnt(" #N ") lgkmcnt(0)\n\ts_barrier" ::: "memory")
typedef __attribute__((address_space(3))) const char* lds_cptr;
typedef short v4i16_t __attribute__((ext_vector_type(4)));
#define LDSB8(p) (*(const __attribute__((address_space(3))) bf16x8*)(p))
__device__ __forceinline__ void kload8(bf16x8* kf, lds_cptr kp) {
  kf[0] = LDSB8(kp);        kf[1] = LDSB8(kp + 512);  kf[2] = LDSB8(kp + 2048); kf[3] = LDSB8(kp + 2560);
  kf[4] = LDSB8(kp + 4096); kf[5] = LDSB8(kp + 4608); kf[6] = LDSB8(kp + 6144); kf[7] = LDSB8(kp + 6656);
}
__device__ __forceinline__ void kload2(bf16x8* kf, lds_cptr kp, int j) { kf[2 * j] = LDSB8(kp + j * 2048); kf[2 * j + 1] = LDSB8(kp + j * 2048 + 512); }
__device__ __forceinline__ s16x4 vtr(lds_cptr p) { return __builtin_bit_cast(s16x4, __builtin_amdgcn_ds_read_tr16_b64_v4i16((__attribute__((address_space(3))) v4i16_t*)p)); }
__device__ __forceinline__ void qkt(f32x16& p0, f32x16& p1, lds_cptr kb, const bf16x8* qr) {
  p0 = f32x16{}; p1 = f32x16{};
#pragma unroll
  for (int d0 = 0; d0 < 4; ++d0) {
    const bf16x8 b0 = LDSB8(kb + d0 * 2048), b1 = LDSB8(kb + d0 * 2048 + 512);
    p0 = __builtin_amdgcn_mfma_f32_32x32x16_bf16(b0, qr[d0], p0, 0, 0, 0); p1 = __builtin_amdgcn_mfma_f32_32x32x16_bf16(b1, qr[d0], p1, 0, 0, 0); }
}
__device__ __forceinline__ void pv(f32x16* o, int vb, bf16x8 pa0, bf16x8 pa1, bf16x8 pa2, bf16x8 pa3) {
#pragma unroll
  for (int d0 = 0; d0 < 4; ++d0) { s16x4 lo[4], hi[4];
#pragma unroll
    for (int ks = 0; ks < 4; ++ks) {
      asm volatile("ds_read_b64_tr_b16 %0,%1 offset:%c2" : "=&v"(lo[ks]) : "v"(vb), "i"(d0 * 4096 + ks * 1024) : "memory");
      asm volatile("ds_read_b64_tr_b16 %0,%1 offset:%c2" : "=&v"(hi[ks]) : "v"(vb), "i"(d0 * 4096 + ks * 1024 + 512) : "memory"); }
    asm volatile("s_waitcnt lgkmcnt(0)" ::: "memory"); SBAR();
#define PK(k) (bf16x8){lo[k][0], lo[k][1], lo[k][2], lo[k][3], hi[k][0], hi[k][1], hi[k][2], hi[k][3]}
    o[d0] = __builtin_amdgcn_mfma_f32_32x32x16_bf16(pa0, PK(0), o[d0], 0, 0, 0);
    o[d0] = __builtin_amdgcn_mfma_f32_32x32x16_bf16(pa1, PK(1), o[d0], 0, 0, 0);
    o[d0] = __builtin_amdgcn_mfma_f32_32x32x16_bf16(pa2, PK(2), o[d0], 0, 0, 0);
    o[d0] = __builtin_amdgcn_mfma_f32_32x32x16_bf16(pa3, PK(3), o[d0], 0, 0, 0);
#undef PK
  }
}
__device__ __forceinline__ void attn_unit(const bf16_t* __restrict__ Qb, const bf16_t* __restrict__ Kh, const bf16_t* __restrict__ Vh, const bf16_t* __restrict__ GAb,
                                          bf16_t* __restrict__ MIXb, int seq, float lam, const float* __restrict__ subw, char* shm) {
  const int tid = threadIdx.x, lane = tid & 63, r32 = lane & 31, hi = lane >> 5; const int wid = __builtin_amdgcn_readfirstlane(tid >> 6);
  const int mp = wid >> 2, qb = wid & 3;
  const bf16_t* Qw = Qb + (long)(qb * 32) * DH + mp * 64;
  const unsigned lds0 = (unsigned)(uintptr_t)shm;
  const bf16_t* ksrc = Kh + (long)lane * DH + wid * 8;
  const bf16_t* vsrc = Vh + (long)(16 * (wid & 3) + (lane >> 2)) * DH + (wid >> 2) * 32 + (lane & 3) * 8;
  const unsigned kdst = lds0 + LDS_K + wid * 1024, vdst = lds0 + LDS_V + wid * 1024;
#define DMA_K(t, slot) do { const bf16_t* s_ = ksrc + (long)(t) * KVBLK * DH; const unsigned d_ = (unsigned)__builtin_amdgcn_readfirstlane(kdst + (slot)); glds16(s_, d_); glds16(s_ + 64, d_ + 8192); } while (0)
#define DMA_V(t, slot) do { const bf16_t* s_ = vsrc + (long)(t) * KVBLK * DH; const unsigned d_ = (unsigned)__builtin_amdgcn_readfirstlane(vdst + (slot)); glds16(s_, d_); glds16(s_ + 64, d_ + 8192); } while (0)
  const int vb0 = (int)(lds0 + LDS_V) + ((lane >> 4) & 1) * 32 + (lane & 3) * 8 + (4 * hi + ((lane & 15) >> 2)) * 64;
  bf16x8 kf[8];
  const lds_cptr shm3 = (lds_cptr)shm; const lds_cptr kp0 = shm3 + LDS_K + mp * 8192 + hi * 1024 + r32 * 16;
  const lds_cptr vp0 = shm3 + LDS_V + ((lane >> 4) & 1) * 32 + (lane & 3) * 8 + (4 * hi + ((lane & 15) >> 2)) * 64;
  const int NT = seq / KVBLK;
  DMA_K(0, 0); DMA_V(0, 0); DMA_K(1, SLOTB);
  bf16x8 qr[4];
#pragma unroll
  for (int d0 = 0; d0 < 4; ++d0) qr[d0] = *reinterpret_cast<const bf16x8*>(&Qw[(long)r32 * DH + d0 * 16 + hi * 8]);
  float l_reg = 0.f; f32x16 o[4]; o[0] = f32x16{}; o[1] = f32x16{}; o[2] = f32x16{}; o[3] = f32x16{};
  f32x16 pA0, pA1, pB0, pB1;
  int sl_prev = 0, sl_cur = 0, sl_next = SLOTB;
#define ROT() do { sl_prev = sl_cur; sl_cur = sl_next; sl_next = (sl_next == (NSLOT - 1) * SLOTB) ? 0 : sl_next + SLOTB; } while (0)
  DMA_K(2, 2 * SLOTB);
  WAIT_BAR(6);
  qkt(pA0, pA1, kp0, qr); asm volatile("s_nop 15\n\ts_nop 7" : "+v"(pA0), "+v"(pA1));
#pragma unroll
  for (int r = 0; r < 16; ++r) { pA0[r] = __builtin_amdgcn_exp2f(pA0[r]); pA1[r] = __builtin_amdgcn_exp2f(pA1[r]); }
  WAIT_BAR(0);
  DMA_K(3, 0); DMA_V(1, SLOTB);
  ROT();
  kload8(kf, kp0 + sl_cur);
  WAIT_BAR(4);
  s16x4 vlo[8], vhi[8], wlo[8], whi[8]; u32x4 pw0, pw1, pw2, pw3;
#define PKW(P, B) cvtpk_s(P[B], P[B + 1])
#define PAF(k) __builtin_bit_cast(bf16x8, pw##k)
#define VFR(i) (bf16x8){vlo[i][0], vlo[i][1], vlo[i][2], vlo[i][3], vhi[i][0], vhi[i][1], vhi[i][2], vhi[i][3]}
#define WFR(i) (bf16x8){wlo[i][0], wlo[i][1], wlo[i][2], wlo[i][3], whi[i][0], whi[i][1], whi[i][2], whi[i][3]}
#define PIN(x) asm volatile("" : "+v"(x))
#define GAPA(MF, A0, A1, A2, A3, W0, W1, PW) do { MF; sacc += A0; sacc += A1; sacc += A2; sacc += A3; PIN(sacc); W0; W1; PIN(PW); SBAR(); } while (0)
#define EX(v) __builtin_amdgcn_exp2f(v)
#define GAPB(MF, X, B) do { MF; X[B] = EX(X[B]); X[B + 1] = EX(X[B + 1]); PIN(X); SBAR(); } while (0)
#define VRD(i) do { vlo[i] = vtr(vp_ + (((i) >> 2) * 4096 + ((i) & 3) * 1024)); vhi[i] = vtr(vp_ + (((i) >> 2) * 4096 + ((i) & 3) * 1024 + 512)); } while (0)
#define WRD(i) do { wlo[i] = vtr(vp_ + 8192 + (((i) >> 2) * 4096 + ((i) & 3) * 1024)); whi[i] = vtr(vp_ + 8192 + (((i) >> 2) * 4096 + ((i) & 3) * 1024 + 512)); SBAR(); } while (0)
#define KRD(G, j) do { if (G) { kload2(kf, kp0 + sl_next, j); SBAR(); } } while (0)
#define MF32(a, b, c) __builtin_amdgcn_mfma_f32_32x32x16_bf16(a, b, c, 0, 0, 0)
#define STEP(C0, C1, P0, P1, t, GK, GV, GL) do { SBAR(); \
    const lds_cptr vp_ = vp0 + sl_prev; \
    VRD(0); SBAR(); float sacc = (P0[0] + P0[1]); \
    GAPA(C0 = MF32(kf[0], qr[0], (f32x16{})), P0[2], P0[3], P0[4], P0[5],     pw0[0] = PKW(P0, 0), pw0[1] = PKW(P0, 2), pw0); \
    VRD(4); SBAR(); GAPA(C1 = MF32(kf[1], qr[0], (f32x16{})), P0[6], P0[7], P0[8], P0[9],     pw0[2] = PKW(P0, 4), pw0[3] = PKW(P0, 6), pw0); \
    VRD(1); SBAR(); GAPA(C0 = MF32(kf[2], qr[1], C0),   P0[10], P0[11], P0[12], P0[13], pw1[0] = PKW(P0, 8), pw1[1] = PKW(P0, 10), pw1); \
    VRD(5); SBAR(); GAPA(C1 = MF32(kf[3], qr[1], C1),   P0[14], P0[15], P1[0], P1[1],   pw1[2] = PKW(P0, 12), pw1[3] = PKW(P0, 14), pw1); \
    VRD(2); SBAR(); GAPA(C0 = MF32(kf[4], qr[2], C0),   P1[2], P1[3], P1[4], P1[5],     pw2[0] = PKW(P1, 0), pw2[1] = PKW(P1, 2), pw2); \
    VRD(6); SBAR(); GAPA(C1 = MF32(kf[5], qr[2], C1),   P1[6], P1[7], P1[8], P1[9],     pw2[2] = PKW(P1, 4), pw2[3] = PKW(P1, 6), pw2); \
    VRD(3); SBAR(); GAPA(C0 = MF32(kf[6], qr[3], C0),   P1[10], P1[11], P1[12], P1[13], pw3[0] = PKW(P1, 8), pw3[1] = PKW(P1, 10), pw3); \
    VRD(7); SBAR(); GAPA(C1 = MF32(kf[7], qr[3], C1),   P1[14], P1[15], 0.f, 0.f,       pw3[2] = PKW(P1, 12), pw3[3] = PKW(P1, 14), pw3); \
    l_reg += sacc; \
    if (GK) { DMA_K((t) + 3, sl_cur); } if (GV) { DMA_V((t) + 1, sl_next); } \
    SBAR(); \
    WRD(0); GAPB(o[0] = MF32(PAF(0), VFR(0), o[0]), C0, 0); \
    WRD(4); GAPB(o[1] = MF32(PAF(0), VFR(4), o[1]), C0, 2); \
    WRD(1); GAPB(o[0] = MF32(PAF(1), VFR(1), o[0]), C0, 4); \
    WRD(5); GAPB(o[1] = MF32(PAF(1), VFR(5), o[1]), C0, 6); \
    WRD(2); GAPB(o[0] = MF32(PAF(2), VFR(2), o[0]), C0, 8); \
    WRD(6); GAPB(o[1] = MF32(PAF(2), VFR(6), o[1]), C0, 10); \
    WRD(3); GAPB(o[0] = MF32(PAF(3), VFR(3), o[0]), C0, 12); \
    WRD(7); GAPB(o[1] = MF32(PAF(3), VFR(7), o[1]), C0, 14); \
    KRD(GL, 0); GAPB(o[2] = MF32(PAF(0), WFR(0), o[2]), C1, 0); \
    KRD(GL, 1); GAPB(o[3] = MF32(PAF(0), WFR(4), o[3]), C1, 2); \
    KRD(GL, 2); GAPB(o[2] = MF32(PAF(1), WFR(1), o[2]), C1, 4); \
    KRD(GL, 3); GAPB(o[3] = MF32(PAF(1), WFR(5), o[3]), C1, 6); \
    GAPB(o[2] = MF32(PAF(2), WFR(2), o[2]), C1, 8); \
    GAPB(o[3] = MF32(PAF(2), WFR(6), o[3]), C1, 10); \
    GAPB(o[2] = MF32(PAF(3), WFR(3), o[2]), C1, 12); \
    GAPB(o[3] = MF32(PAF(3), WFR(7), o[3]), C1, 14); \
    } while (0)
  int t = 1;
  for (; t + 5 < NT; t += 2) {
    STEP(pB0, pB1, pA0, pA1, t, true, true, true);     WAIT_BAR(4); ROT();
    STEP(pA0, pA1, pB0, pB1, t + 1, true, true, true); WAIT_BAR(4); ROT();
  }
#define ENDW(tt) do { if ((tt) + 3 < NT) { WAIT_BAR(4); } else if ((tt) + 2 < NT) { WAIT_BAR(2); } else { WAIT_BAR(0); } } while (0)
  for (; t + 1 < NT; t += 2) {
    STEP(pB0, pB1, pA0, pA1, t, (t + 3 < NT), (t + 1 < NT), (t + 1 < NT));         ENDW(t);     ROT();
    STEP(pA0, pA1, pB0, pB1, t + 1, (t + 4 < NT), (t + 2 < NT), (t + 2 < NT));     ENDW(t + 1); ROT();
  }
  STEP(pB0, pB1, pA0, pA1, NT - 1, false, false, false);
  { float sacc = pB0[0] + pB0[1];
#pragma unroll
    for (int r = 2; r < 16; ++r) sacc += pB0[r];
#pragma unroll
    for (int r = 0; r < 16; ++r) sacc += pB1[r];
    l_reg += sacc;
    pw0 = (u32x4){PKW(pB0, 0), PKW(pB0, 2), PKW(pB0, 4), PKW(pB0, 6)}; pw1 = (u32x4){PKW(pB0, 8), PKW(pB0, 10), PKW(pB0, 12), PKW(pB0, 14)};
    pw2 = (u32x4){PKW(pB1, 0), PKW(pB1, 2), PKW(pB1, 4), PKW(pB1, 6)}; pw3 = (u32x4){PKW(pB1, 8), PKW(pB1, 10), PKW(pB1, 12), PKW(pB1, 14)};
    SBAR(); pv(o, vb0 + sl_cur, PAF(0), PAF(1), PAF(2), PAF(3)); }
#undef PKW
#undef PAF
#undef VFR
#undef WFR
#undef PIN
#undef GAPA
#undef GAPB
#undef EX
#undef VRD
#undef WRD
#undef KRD
#undef STEP
#undef ENDW
#undef MF32
#undef DMA_K
#undef DMA_V
#undef ROT
  int tid_e = tid; asm volatile("" : "+v"(tid_e));
  const int lane_e = tid_e & 63, r32e = lane_e & 31, hie = lane_e >> 5, wide = tid_e >> 6, mpe = wide >> 2, qbe = wide & 3;
  { auto rr = __builtin_amdgcn_permlane32_swap(__float_as_uint(l_reg), __float_as_uint(l_reg), false, false); l_reg = __uint_as_float(rr[0]) + __uint_as_float(rr[1]); }
  float* wse = (float*)(shm + LDS_WS) + wide * 64;
  if (hie == 0) wse[r32e] = l_reg;
  asm volatile("s_waitcnt lgkmcnt(0)" ::: "memory");
  float rli[16];
#pragma unroll
  for (int r = 0; r < 16; ++r) rli[r] = __builtin_amdgcn_rcpf(wse[crow(r, hie)]);
  float* OL = (float*)shm;
  asm volatile("s_waitcnt vmcnt(0) lgkmcnt(0)" ::: "memory"); __syncthreads();
  if (mpe == 1) {
#pragma unroll
    for (int r = 0; r < 16; ++r) { const int row = qbe * 32 + crow(r, hie); const float f = lam * rli[r];
#pragma unroll
      for (int d0 = 0; d0 < 4; ++d0) OL[row * OL_PITCH + d0 * 32 + r32e] = o[d0][r] * f; }
  }
  __syncthreads();
  if (mpe == 0) {
#pragma unroll
    for (int r = 0; r < 16; ++r) { const int row = qbe * 32 + crow(r, hie);
#pragma unroll
      for (int d0 = 0; d0 < 4; ++d0) { float* p = OL + row * OL_PITCH + d0 * 32 + r32e; *p = o[d0][r] * rli[r] - *p; } }
  }
  __syncthreads();
  { const int row = tid_e >> 2, q = tid_e & 3; const float* src = OL + row * OL_PITCH + q * 32;
    f32x4 a[8]; float ss = 0.f;
#pragma unroll
    for (int i = 0; i < 8; ++i) { a[i] = *(const f32x4*)(src + 4 * i); const f32x4 s2 = a[i] * a[i]; ss += (s2[0] + s2[1]) + (s2[2] + s2[3]); }
    ss += __shfl_xor(ss, 1); ss += __shfl_xor(ss, 2);
    const float rs = (1.0f - LAM_INIT) / sqrtf(ss * (1.0f / 128.0f) + RMS_EPS);
    const bf16_t* gp = GAb + (long)row * DH + q * 32; bf16_t* mpo = MIXb + (long)row * DM + q * 32; const float* wp = subw + q * 32;
#pragma unroll
    for (int i = 0; i < 4; ++i) { const u32x4 gv = *(const u32x4*)(gp + 8 * i); const f32x4 w0 = *(const f32x4*)(wp + 8 * i), w1 = *(const f32x4*)(wp + 8 * i + 4);
      const f32x4 x0 = a[2 * i] * rs * w0, x1 = a[2 * i + 1] * rs * w1;
      f32x4 g0, g1; g0[0] = __uint_as_float(gv.x << 16); g0[1] = __uint_as_float(gv.x & 0xffff0000u); g0[2] = __uint_as_float(gv.y << 16); g0[3] = __uint_as_float(gv.y & 0xffff0000u);
      g1[0] = __uint_as_float(gv.z << 16); g1[1] = __uint_as_float(gv.z & 0xffff0000u); g1[2] = __uint_as_float(gv.w << 16); g1[3] = __uint_as_float(gv.w & 0xffff0000u);
      const f32x4 y0 = x0 * g0, y1 = x1 * g1; u32x4 w; w.x = cvtpk_s(y0[0], y0[1]); w.y = cvtpk_s(y0[2], y0[3]); w.z = cvtpk_s(y1[0], y1[1]); w.w = cvtpk_s(y1[2], y1[3]);
      *(u32x4*)(mpo + 8 * i) = w; }
  }
  asm volatile("s_waitcnt lgkmcnt(0)\n\ts_barrier" ::: "memory");
}
#undef SBAR
#undef WAIT_BAR
#undef LDSB8
}
#define GAS __attribute__((address_space(1)))
#define LAS __attribute__((address_space(3)))
typedef unsigned short bf16;
typedef unsigned v4u __attribute__((ext_vector_type(4)));
typedef float f32x4 __attribute__((ext_vector_type(4)));
typedef short bf16x8 __attribute__((ext_vector_type(8)));
typedef GAS unsigned gu32;
typedef GAS unsigned long long gu64;
#define RLX_AGENT __ATOMIC_RELAXED, __HIP_MEMORY_SCOPE_AGENT
#define LDS_WAIT() asm volatile("s_waitcnt lgkmcnt(0)" ::: "memory")
#define VM_WAIT() asm volatile("s_waitcnt vmcnt(0)" ::: "memory")
__device__ __forceinline__ unsigned long long rt() { return __builtin_amdgcn_s_memrealtime(); }
__device__ __forceinline__ unsigned f2bf(float f) { unsigned u = __builtin_bit_cast(unsigned, f); return (u + 0x7fffu + ((u >> 16) & 1u)) >> 16; }
__device__ __forceinline__ unsigned pk2(float lo, float hi) { return f2bf(lo) | (f2bf(hi) << 16); }

#define XB_TMO      128
#define XB_XCNT(j)  (256  + 64 * (j))
#define XB_XSUB(j)  (1280 + 64 * (j))
#define XB_XGEN(j)  (2304 + 64 * (j))
#define XB_TOP      3328
#define XB_TOPGEN   3392
#define XCD_BAR_WORDS 3456
#define XB_SPIN_CAP (1u << 18)

__device__ __forceinline__ unsigned xb_ld(unsigned* p)              { return __hip_atomic_load(p, __ATOMIC_RELAXED, __HIP_MEMORY_SCOPE_AGENT); }
__device__ __forceinline__ unsigned xb_add(unsigned* p, unsigned v) { return __hip_atomic_fetch_add(p, v, __ATOMIC_RELAXED, __HIP_MEMORY_SCOPE_AGENT); }
__device__ __forceinline__ unsigned xb_xcc_id() { return (unsigned)__builtin_amdgcn_s_getreg((3 << 11) | 20) & 0xFu; }
#define XB_SPIN(cond, bar) do { unsigned _sp = 0; while (cond) { __builtin_amdgcn_s_sleep(1); \
    if ((++_sp & 255u) == 0u) { if (xb_ld(&(bar)[XB_TMO])) break; if (_sp > XB_SPIN_CAP) { atomicAdd(&(bar)[XB_TMO], 1u); break; } } } } while (0)

struct XcdBarrier {
    unsigned* bar; unsigned x;
    volatile LAS unsigned* st;
};

__device__ __forceinline__ XcdBarrier xcd_barrier_post(unsigned* bar, volatile LAS unsigned* st) {
    XcdBarrier b; b.bar = bar; b.x = xb_xcc_id(); b.st = st;
    if (threadIdx.x == 0) (void)xb_add(&bar[XB_XCNT(b.x)], 1u);
    return b;
}
__device__ __forceinline__ void xcd_barrier_complete(unsigned* bar, unsigned x, unsigned& nloc, unsigned& nx) {
    const unsigned G = gridDim.x * gridDim.y * gridDim.z;
    unsigned sum, cnt, mine, sp = 0u;
    for (;;) {
        sum = 0u; cnt = 0u; mine = 0u;
#pragma unroll
        for (unsigned j = 0; j < 16; ++j) { const unsigned c = xb_ld(&bar[XB_XCNT(j)]); sum += c; cnt += (c > 0u) ? 1u : 0u; mine = (j == x) ? c : mine; }
        if (sum == G) break;
        __builtin_amdgcn_s_sleep(1);
        if ((++sp & 255u) == 0u) { if (xb_ld(&bar[XB_TMO])) break; if (sp > XB_SPIN_CAP) { atomicAdd(&bar[XB_TMO], 1u); break; } }
    }
    nloc = mine > 0u ? mine : 1u; nx = cnt > 0u ? cnt : 1u;
}

__device__ __forceinline__ void xcd_barrier(const XcdBarrier& b) {
    asm volatile("s_waitcnt vmcnt(0)" ::: "memory");
    __syncthreads();
    if (threadIdx.x == 0) {
        unsigned* bar = b.bar;
        __builtin_amdgcn_s_waitcnt(0);
        unsigned nloc = b.st[0], nx = b.st[1];
        if (nloc == 0u) { xcd_barrier_complete(bar, b.x, nloc, nx); b.st[0] = nloc; b.st[1] = nx; }
        const unsigned old = xb_add(&bar[XB_XSUB(b.x)], 1u);
        const unsigned gen = old / nloc;
        if (old + 1u == (gen + 1u) * nloc) {
            __builtin_amdgcn_fence(__ATOMIC_RELEASE, "agent");
            asm volatile("s_waitcnt vmcnt(0)" ::: "memory");
            const unsigned og = xb_add(&bar[XB_TOP], 1u);
            const unsigned tg = og / nx;
            if (og + 1u == (tg + 1u) * nx) xb_add(&bar[XB_TOPGEN], 1u);
            else XB_SPIN(xb_ld(&bar[XB_TOPGEN]) == tg, bar);
            __builtin_amdgcn_fence(__ATOMIC_ACQUIRE, "agent");
            xb_add(&bar[XB_XGEN(b.x)], 1u);
            asm volatile("s_waitcnt vmcnt(0)" ::: "memory");
        } else {
            XB_SPIN(xb_ld(&bar[XB_XGEN(b.x)]) == gen, bar);
            __builtin_amdgcn_fence(__ATOMIC_ACQUIRE, "agent");
            asm volatile("s_waitcnt vmcnt(0)" ::: "memory");
        }
    }
    __syncthreads();
}

constexpr size_t MiB = 1u << 20;
constexpr size_t WS_CTL = 0, CTL_ZERO_BYTES = 1 * MiB;
constexpr int CW_BAR = 4096;
constexpr size_t WS_MODACC = 256 * 1024;
constexpr size_t WS_GATE = 1 * MiB;
constexpr size_t WS_ROPE = 1 * MiB + 64 * 1024;
constexpr size_t WS_WIN = 2 * MiB, WS_WOUT = 10 * MiB;
constexpr size_t WS_H = 16 * MiB;
constexpr size_t WS_Q = 88 * MiB;
constexpr size_t WS_K = 124 * MiB, WS_V = 162 * MiB;
constexpr size_t WS_GA = 200 * MiB, WS_U = 236 * MiB, WS_CBG = 272 * MiB;
constexpr size_t WS_MIX = 308 * MiB, WS_END = 380 * MiB;
static_assert(WS_MODACC + 9 * 3072 * 8 <= CTL_ZERO_BYTES && WS_ROPE + 2 * 64 * 16 * 4 <= WS_WIN && WS_WIN + (size_t)DIN * DM * 2 <= WS_WOUT && WS_WOUT + (size_t)DM * DM * 2 <= WS_H, "ws map 1");
static_assert(WS_H + (size_t)MROWS * DM * 2 <= WS_Q && WS_Q + (size_t)MROWS * DH * 2 <= WS_K && WS_K + (size_t)KVROWS * DH * 2 <= WS_V && WS_V + (size_t)KVROWS * DH * 2 <= WS_GA, "ws map 2");
static_assert(WS_GA + (size_t)MROWS * DH * 2 <= WS_U && WS_U + (size_t)MROWS * DH * 2 <= WS_CBG && WS_CBG + (size_t)MROWS * DH * 2 <= WS_MIX && WS_MIX + (size_t)MROWS * DM * 2 <= WS_END, "ws map 3");
constexpr size_t OUT_Y = 0, OUT_NCK = (size_t)MROWS * DM, OUT_NCV = OUT_NCK + (size_t)MC * DH, OUT_END = OUT_NCV + (size_t)MC * DH;

constexpr int NWAVES = 8;
constexpr int RING_OFF = 0, RING_BYTES = 131072;
constexpr int LDSCTL_OFF = RING_BYTES, MISC_OFF = LDSCTL_OFF + 320;
constexpr int LDS_BYTES = 147456;
static_assert(att2::ATT_LDS_BYTES <= RING_BYTES && MISC_OFF + 128 <= LDS_BYTES, "LDS map");
constexpr int N_PHASES = 5;
#ifndef MK_ONE_LAUNCH
#define MK_ONE_LAUNCH 1
#endif

__device__ __forceinline__ float wave_sum(float v) {
#pragma unroll
    for (int o = 1; o < 64; o <<= 1) v += __shfl_xor(v, o);
    return v;
}
template <class Dest>
__device__ __forceinline__ void p0_transpose_item(const float* W, int K, int N, bf16* WT, LAS float* scr, int item, int lane, Dest dest) {
    const int nblk = N / 32, kb = item / nblk, nb = item % nblk, k0 = 64 * kb, n0 = 32 * nb;
#pragma unroll 8
    for (int i = 0; i < 32; ++i) { const int kk = 2 * i + (lane >> 5); scr[kk * 33 + (lane & 31)] = W[(size_t)(k0 + kk) * N + n0 + (lane & 31)]; }
    LDS_WAIT(); asm volatile("" ::: "memory");
    const int c = lane & 7;
#pragma unroll
    for (int j = 0; j < 4; ++j) { const int n = (lane >> 3) + 8 * j; const LAS float* s = scr + (8 * c) * 33 + n;
        v4u o; o.x = pk2(s[0 * 33], s[1 * 33]); o.y = pk2(s[2 * 33], s[3 * 33]); o.z = pk2(s[4 * 33], s[5 * 33]); o.w = pk2(s[6 * 33], s[7 * 33]);
        *(GAS v4u*)(WT + (size_t)dest(n0 + n) * K + k0 + 8 * c) = o; }
    LDS_WAIT(); asm volatile("" ::: "memory");
}
struct DestWin { __device__ __forceinline__ int operator()(int s) const { return pg8::win_dest_row(s); } };
struct DestId  { __device__ __forceinline__ int operator()(int s) const { return s; } };
__device__ __forceinline__ float fix2f(unsigned long long v) { return (float)((double)(long long)v * (1.0 / 4294967296.0)); }

struct Args { const float* in[20]; float* out; unsigned char* ws; int ph_lo, ph_hi; };

__global__ void __launch_bounds__(NWAVES * 64, 2) hymba_fwd(Args args) {
    extern __shared__ __attribute__((aligned(16))) unsigned char lds_raw[];
    LAS unsigned char* lds = (LAS unsigned char*)lds_raw;
    volatile LAS unsigned* MISC = (volatile LAS unsigned*)(lds + MISC_OFF);
    const int tid = threadIdx.x, lane = tid & 63, wave = __builtin_amdgcn_readfirstlane(tid >> 6);
    const int G = gridDim.x; const int vcu = (G % 8 == 0) ? ((int)blockIdx.x % 8) * (G / 8) + (int)blockIdx.x / 8 : (int)blockIdx.x;
    unsigned char* ws = args.ws;
    gu32* ctl = (gu32*)(ws + WS_CTL);
    const float* x_prompt = args.in[0]; const float* x_sample = args.in[1]; const float* cache_k = args.in[2]; const float* cache_v = args.in[3];
    const float* cvec = args.in[4]; const float* c_ctx = args.in[5]; const float* norm_w = args.in[6]; const float* w_ada = args.in[7]; const float* b_ada = args.in[8];
    const float* w_in = args.in[9]; const float* q_norm_w = args.in[10]; const float* k_norm_w = args.in[11];
    const float* lq1 = args.in[12]; const float* lk1 = args.in[13]; const float* lq2 = args.in[14]; const float* lk2 = args.in[15];
    const float* subln_w = args.in[16]; const float* conv_w = args.in[17]; const float* conv_b = args.in[18]; const float* w_out = args.in[19];
    float* out = args.out;
    unsigned long long* modacc = (unsigned long long*)(ws + WS_MODACC);
    float* gate = (float*)(ws + WS_GATE); float* ropec = (float*)(ws + WS_ROPE); float* ropes = ropec + 64 * 16;
    bf16* Win_t = (bf16*)(ws + WS_WIN); bf16* Wout_t = (bf16*)(ws + WS_WOUT); bf16* Hb = (bf16*)(ws + WS_H);
    bf16* Qb = (bf16*)(ws + WS_Q); bf16* Kb = (bf16*)(ws + WS_K); bf16* Vb = (bf16*)(ws + WS_V);
    bf16* GAb = (bf16*)(ws + WS_GA); bf16* Ub = (bf16*)(ws + WS_U); bf16* CBGb = (bf16*)(ws + WS_CBG); bf16* MIXb = (bf16*)(ws + WS_MIX);

    for (int u = tid; u < (LDS_BYTES - LDSCTL_OFF) / 4; u += NWAVES * 64) ((LAS unsigned*)(lds + LDSCTL_OFF))[u] = 0u;
    __syncthreads();
    const int lo = args.ph_lo, hi = args.ph_hi;
    const bool use_bar = (hi - lo) > 1;
    XcdBarrier bar; bar.bar = (unsigned*)(ctl + CW_BAR); bar.x = 0; bar.st = nullptr;
    if (use_bar) bar = xcd_barrier_post((unsigned*)(ctl + CW_BAR), MISC + 8);
#ifndef PHMASK
#define PHMASK 31
#endif
#define IN(k) (((PHMASK >> (k)) & 1) && lo <= (k) && (k) < hi)
#define SEAM(k) do { if (IN(k) && IN((k) + 1)) xcd_barrier(bar); } while (0)
    const int gw = vcu * NWAVES + wave, NGW = G * NWAVES;

    if (IN(0)) {
        LAS float* scr = (LAS float*)(lds + RING_OFF + wave * 16384);
        constexpr int I_IN = (DM / 64) * (DIN / 32), I_OUT = (DM / 64) * (DM / 32), I_MOD = 48 * 16;
        for (int it = gw; it < I_MOD + I_IN + I_OUT; it += NGW) {
            int r = it;
            if (r < I_MOD) {
                const int cc = r % 48, kc = r / 48, col = cc * 64 + lane, k0 = kc * 64;
                float sv[9], acc[9];
#pragma unroll
                for (int b = 0; b < 9; ++b) { const float cv = (b == 0) ? c_ctx[k0 + lane] : cvec[(b - 1) * DM + k0 + lane]; sv[b] = cv / (1.0f + expf(-cv)); acc[b] = 0.f; }
#pragma unroll 8
                for (int kk = 0; kk < 64; ++kk) { const float w = w_ada[(size_t)(k0 + kk) * (3 * DM) + col];
#pragma unroll
                    for (int b = 0; b < 9; ++b) acc[b] = fmaf(__uint_as_float(__builtin_amdgcn_readlane(__float_as_uint(sv[b]), kk)), w, acc[b]); }
#pragma unroll
                for (int b = 0; b < 9; ++b) { const long long q = __float2ll_rn(acc[b] * 4294967296.0f);
                    __hip_atomic_fetch_add(modacc + b * (3 * DM) + col, (unsigned long long)q, __ATOMIC_RELAXED, __HIP_MEMORY_SCOPE_AGENT); }
                continue; }
            r -= I_MOD;
            if (r < I_IN) { p0_transpose_item(w_in, DM, DIN, Win_t, scr, r, lane, DestWin()); continue; }
            r -= I_IN;
            p0_transpose_item(w_out, DM, DM, Wout_t, scr, r, lane, DestId());
        }
        for (int i = gw * 64 + lane; i < 2 * NLATB * PAST * DH / 8; i += NGW * 64) {
            const int half = NLATB * PAST * DH / 8; const bool isv = i >= half; const int e = (isv ? i - half : i) * 8;
            const int b = e / (PAST * DH), j = (e / DH) % PAST, c = e % DH;
            const float* src = (isv ? cache_v : cache_k) + e; const f32x4 a = *(const f32x4*)src, bb = *(const f32x4*)(src + 4);
            v4u o; o.x = pk2(a[0], a[1]); o.y = pk2(a[2], a[3]); o.z = pk2(bb[0], bb[1]); o.w = pk2(bb[2], bb[3]);
            *(v4u*)((isv ? Vb : Kb) + (size_t)(MC + b * KVL + SEQL + j) * DH + c) = o;
        }
        if (blockIdx.x == 0) { for (int i = tid; i < 64 * 16; i += NWAVES * 64) { const int p = i >> 4, f = i & 15;
            const float inv = 1.0f / powf(10000.0f, (float)f / 16.0f); const float ang = (float)p * inv; ropec[i] = cosf(ang); ropes[i] = sinf(ang); } }
    }
    SEAM(0);
    if (IN(1)) {
        LAS float* gs = (LAS float*)(lds + RING_OFF);
        for (int i = blockIdx.x * (NWAVES * 64) + tid; i < 9 * DM; i += G * NWAVES * 64) { const int b = i >> 10, j = i & 1023;
            gate[i] = fix2f(__hip_atomic_load(modacc + b * (3 * DM) + 2 * DM + j, RLX_AGENT)) + b_ada[2 * DM + j]; }
        const int rows_per = (MROWS + G - 1) / G;
        const int r0 = (int)blockIdx.x * rows_per, r1 = (r0 + rows_per < MROWS) ? r0 + rows_per : MROWS;
        if (r0 < r1) {
            const int mb_lo = r0 < MC ? 0 : 1 + ((r0 - MC) >> 12), mb_hi = (r1 - 1) < MC ? 0 : 1 + ((r1 - 1 - MC) >> 12);
            for (int i = tid; i < 2 * DM; i += NWAVES * 64) { const int slot = i >> 10, k = i & 1023, mb = slot ? mb_hi : mb_lo;
                const float shift = fix2f(__hip_atomic_load(modacc + mb * (3 * DM) + k, RLX_AGENT)) + b_ada[k];
                const float scale = fix2f(__hip_atomic_load(modacc + mb * (3 * DM) + DM + k, RLX_AGENT)) + b_ada[DM + k];
                gs[slot * 2048 + k] = norm_w[k] * (1.0f + scale); gs[slot * 2048 + 1024 + k] = shift; }
            __syncthreads();
            for (int row = r0 + wave; row < r1; row += NWAVES) {
                const int mb = row < MC ? 0 : 1 + ((row - MC) >> 12); const LAS float* gp = gs + (mb != mb_lo ? 2048 : 0);
                const float* xrow = row < MC ? x_prompt + (size_t)row * DM : x_sample + (size_t)(row - MC) * DM;
                const GAS f32x4* xr = (const GAS f32x4*)xrow + lane;
                f32x4 v[4]; float s2 = 0.f;
#pragma unroll
                for (int j = 0; j < 4; ++j) { v[j] = xr[64 * j]; s2 += (v[j].x * v[j].x + v[j].y * v[j].y) + (v[j].z * v[j].z + v[j].w * v[j].w); }
                const float rstd = 1.0f / sqrtf(wave_sum(s2) * (1.0f / DM) + RMS_EPS);
                GAS unsigned long long* o8 = (GAS unsigned long long*)(Hb + (size_t)row * DM) + lane;
#pragma unroll
                for (int j = 0; j < 4; ++j) { const f32x4 g4 = *(const LAS f32x4*)(gp + 256 * j + 4 * lane), s4 = *(const LAS f32x4*)(gp + 1024 + 256 * j + 4 * lane);
                    const f32x4 h4 = (v[j] * rstd) * g4 + s4;
                    o8[64 * j] = (unsigned long long)pk2(h4.x, h4.y) | ((unsigned long long)pk2(h4.z, h4.w) << 32); }
            }
        }
        __syncthreads();
    }
    SEAM(1);
    if (IN(2)) {
        pg8::Gemm g{Hb, Win_t, MROWS, DIN, DM}; pg8::StaticOrder S; S.init(MROWS, DIN, G, (int)blockIdx.x);
        pg8::EpiProj E{Qb, Kb, Vb, GAb, Ub, CBGb, out + OUT_NCK, out + OUT_NCV, q_norm_w, k_norm_w, ropec, ropes};
        pg8::gemm_phase<pg8::EpiProj, pg8::StaticOrder, true, true>(lds + RING_OFF, g, S, E);
    }
    SEAM(2);
    if (IN(3)) {
        {
            float w0[8], w1[8], w2[8], bb[8];
#pragma unroll
            for (int e = 0; e < 8; ++e) { const int c = 8 * lane + e; w0[e] = conv_w[c]; w1[e] = conv_w[DH + c]; w2[e] = conv_w[2 * DH + c]; bb[e] = conv_b[c]; }
            const int rows_per = (MROWS + NGW - 1) / NGW;
            const int r0 = gw * rows_per, r1 = (r0 + rows_per < MROWS) ? r0 + rows_per : MROWS;
#pragma unroll 2
            for (int row = r0; row < r1; ++row) {
                const int t = row < MC ? (row & (SEQC - 1)) : ((row - MC) & (SEQL - 1)), last = row < MC ? SEQC - 1 : SEQL - 1;
                const v4u z = {0u, 0u, 0u, 0u};
                const v4u uc = *(const v4u*)(Ub + (size_t)row * DH + 8 * lane);
                const v4u up = t > 0 ? *(const v4u*)(Ub + (size_t)(row - 1) * DH + 8 * lane) : z;
                const v4u un = t < last ? *(const v4u*)(Ub + (size_t)(row + 1) * DH + 8 * lane) : z;
                const v4u cg = *(const v4u*)(CBGb + (size_t)row * DH + 8 * lane);
                float r[8];
#pragma unroll
                for (int e = 0; e < 4; ++e) {
                    const unsigned a = up[e], b = uc[e], c = un[e], d = cg[e];
                    const float lo_ = fmaf(w0[2 * e], __uint_as_float(a << 16), fmaf(w1[2 * e], __uint_as_float(b << 16), fmaf(w2[2 * e], __uint_as_float(c << 16), bb[2 * e])));
                    const float hi_ = fmaf(w0[2 * e + 1], __uint_as_float(a & 0xffff0000u), fmaf(w1[2 * e + 1], __uint_as_float(b & 0xffff0000u), fmaf(w2[2 * e + 1], __uint_as_float(c & 0xffff0000u), bb[2 * e + 1])));
                    r[2 * e] = lo_ * __uint_as_float(d << 16); r[2 * e + 1] = hi_ * __uint_as_float(d & 0xffff0000u);
                }
                v4u o; o.x = pk2(r[0], r[1]); o.y = pk2(r[2], r[3]); o.z = pk2(r[4], r[5]); o.w = pk2(r[6], r[7]);
                *(v4u*)(MIXb + (size_t)row * DM + DH + 8 * lane) = o;
            }
        }
        float lam;
        { const float a = wave_sum(lq1[lane] * lk1[lane]), b = wave_sum(lq2[lane] * lk2[lane]); lam = expf(a) - expf(b) + LAM_INIT; }
        const int per_x = (G % 8 == 0) ? G / 8 : 0;
        const int n_lat = NLATB * 4 * (SEQL / 128), n_ctx = NCTXB * 4 * 2;
        for (int i = 0;; ++i) {
            int un;
            if (per_x >= 32) { const int xcd = vcu / per_x, ci = vcu % per_x;
                if (i < 4) { if (ci >= 32) continue; un = (8 * i + xcd) * 32 + ci; }
                else { un = n_lat + (i - 4) * G + vcu; if (un >= n_lat + n_ctx) break; } }
            else { un = i * G + (int)blockIdx.x; if (un >= n_lat + n_ctx) break; }
            size_t qrow, krow0; int seq, h;
            if (un < n_lat) { const int bh = un >> 5, qb = un & 31, b = bh >> 2; h = bh & 3; qrow = (size_t)MC + (size_t)b * SEQL + (size_t)qb * 128; krow0 = (size_t)MC + (size_t)b * KVL; seq = KVL; }
            else { const int uc = un - n_lat, b = uc >> 3, qb = uc & 1; h = (uc >> 1) & 3; qrow = (size_t)b * SEQC + (size_t)qb * 128; krow0 = (size_t)b * SEQC; seq = SEQC; }
            att2::attn_unit(Qb + qrow * DH + h * 128, Kb + krow0 * DH + h * 128, Vb + krow0 * DH + h * 128, GAb + qrow * DH + h * 128, MIXb + qrow * DM + h * 128, seq, lam, subln_w, (char*)lds_raw + RING_OFF);
        }
        __syncthreads();
    }
    SEAM(3);
    if (IN(4)) {
        pg8::Gemm g{MIXb, Wout_t, MROWS, DM, DM}; pg8::StaticOrder S; S.init(MROWS, DM, G, (int)blockIdx.x);
        pg8::EpiOut E{x_prompt, x_sample, gate, out + OUT_Y};
        pg8::gemm_phase<pg8::EpiOut, pg8::StaticOrder, true, true>(lds + RING_OFF, g, S, E);
    }
#undef IN
#undef SEAM
}

extern "C" void kernel_launch(void* const* d_in, const int* in_sizes, int n_in, void* d_out, int out_size, void* d_ws, size_t ws_size, hipStream_t stream) {
    static int grid = 0;
    if (grid == 0) {
        if (n_in != 20 || in_sizes[0] != MC * DM || in_sizes[1] != ML * DM || (size_t)out_size != OUT_END || ws_size < WS_END) {
            fprintf(stderr, "kernel_launch: shape mismatch: n_in %d in0 %d in1 %d out %d ws %zu (need >= %zu)\n", n_in, n_in > 0 ? in_sizes[0] : -1, n_in > 1 ? in_sizes[1] : -1, out_size, ws_size, (size_t)WS_END);
            grid = -1; return; }
        int dev = 0, cus = 0, per_cu = 0;
        if (hipGetDevice(&dev) != hipSuccess || hipDeviceGetAttribute(&cus, hipDeviceAttributeMultiprocessorCount, dev) != hipSuccess) { fprintf(stderr, "kernel_launch: device query failed\n"); grid = -1; return; }
        if (hipFuncSetAttribute((const void*)hymba_fwd, hipFuncAttributeMaxDynamicSharedMemorySize, LDS_BYTES) != hipSuccess) { fprintf(stderr, "kernel_launch: hipFuncSetAttribute failed\n"); grid = -1; return; }
        if (hipOccupancyMaxActiveBlocksPerMultiprocessor(&per_cu, (const void*)hymba_fwd, NWAVES * 64, LDS_BYTES) != hipSuccess || per_cu < 1)
            fprintf(stderr, "kernel_launch: note: occupancy query reports %d workgroups per CU\n", per_cu);
        (void)hipGetLastError();
        grid = cus;
        if (grid != 256) fprintf(stderr, "kernel_launch: note: %d CUs (tuned for 256)\n", grid);
    }
    if (grid < 0) return;
    if (hipMemsetAsync((char*)d_ws + WS_CTL, 0, CTL_ZERO_BYTES, stream) != hipSuccess) { fprintf(stderr, "kernel_launch: memset failed\n"); return; }
    Args a{};
    for (int i = 0; i < 20; ++i) a.in[i] = (const float*)d_in[i];
    a.out = (float*)d_out; a.ws = (unsigned char*)d_ws;
#if MK_ONE_LAUNCH
    a.ph_lo = 0; a.ph_hi = N_PHASES;
    hipLaunchKernelGGL(hymba_fwd, dim3(grid), dim3(NWAVES * 64), LDS_BYTES, stream, a);
#ifdef PROBE_EXTRA_PHASE
    a.ph_lo = PROBE_EXTRA_PHASE; a.ph_hi = PROBE_EXTRA_PHASE + 1;
    hipLaunchKernelGGL(hymba_fwd, dim3(grid), dim3(NWAVES * 64), LDS_BYTES, stream, a);
#endif
#else
    for (int p = 0; p < N_PHASES; ++p) { a.ph_lo = p; a.ph_hi = p + 1; hipLaunchKernelGGL(hymba_fwd, dim3(grid), dim3(NWAVES * 64), LDS_BYTES, stream, a); }
#endif
    const hipError_t le = hipPeekAtLastError();
    if (le != hipSuccess) fprintf(stderr, "kernel_launch: launch failed: %s\n", hipGetErrorName(le));
}
```
